# Optimizing an MI355X kernel written in HIP

```python
import math
import numpy as np
import jax
import jax.numpy as jnp
from jax import lax

D_MODEL = 1024
BATCH = 16
SEQ = 2048
DEPTH = 4

GRID_W = 64
CTX_LEN = 256
DN_HEADS = 4
DN_HEAD_DIM = 128
DN_WIDTH = DN_HEADS * DN_HEAD_DIM
DN_CONV = 3
DN_CHUNK = 64
SC_WIDTH = 512
SC_CONV = 3
NA_HEADS = 8
NA_HEAD_DIM = 64
NA_WIDTH = NA_HEADS * NA_HEAD_DIM
NA_WIN_R = 8
NA_WIN_C = 16
NA_QBLK_C = 16
NA_KBLK_C = 32
D_FF = 2816
FFN_CONV = 3
N_BRANCH = 3
ROPE_BASE = 10000.0
EPS = 1e-6
IN_SPLITS = (3 * DN_WIDTH, DN_WIDTH, 2 * DN_HEADS, 2 * DN_HEADS, 3 * SC_WIDTH, 3 * NA_WIDTH, N_BRANCH * D_MODEL)
N_IN = sum(IN_SPLITS)

kernel_name = 'hybrid_dit_gdn_shortconv_natten_convffn'


def rms_norm(x, g):
    x32 = x.astype(jnp.float32)
    y = x32 * lax.rsqrt(jnp.mean(x32 * x32, axis=-1, keepdims=True) + EPS)
    return (y * g.astype(jnp.float32)).astype(x.dtype)


def l2norm(x):
    x32 = x.astype(jnp.float32)
    return x32 * lax.rsqrt(jnp.sum(x32 * x32, axis=-1, keepdims=True) + EPS)


def dwconv(x, w):
    K = w.shape[0]
    T = x.shape[1]
    lo = (K - 1) // 2
    xp = jnp.pad(x, ((0, 0), (lo, K - 1 - lo), (0, 0)))
    out = xp[:, 0:T] * w[0]
    for i in range(1, K):
        out = out + xp[:, i:i + T] * w[i]
    return out


def split_cols(p):
    pts = np.cumsum(IN_SPLITS)[:-1].tolist()
    return jnp.split(p, pts, axis=-1)


def axial_rope(T, dim):
    t = jnp.arange(T, dtype=jnp.int32)
    rows = (t // GRID_W).astype(jnp.float32)
    cols = (t % GRID_W).astype(jnp.float32)
    nf = dim // 4
    inv = ROPE_BASE ** (-jnp.arange(nf, dtype=jnp.float32) / nf)
    ang = jnp.concatenate([rows[:, None] * inv, cols[:, None] * inv], axis=-1)
    return jnp.cos(ang), jnp.sin(ang)


def apply_rope(x, cos, sin):
    x1 = x[..., 0::2]
    x2 = x[..., 1::2]
    return jnp.stack([x1 * cos - x2 * sin, x1 * sin + x2 * cos], axis=-1).reshape(x.shape)


def chunk_gated_delta(q, k, v, g, beta, S0):
    B, H, T, dk = q.shape
    dv = v.shape[-1]
    C = DN_CHUNK
    N = T // C
    q = (q * dk ** -0.5).reshape(B, H, N, C, dk)
    k = k.reshape(B, H, N, C, dk)
    v = v.reshape(B, H, N, C, dv)
    beta = beta.reshape(B, H, N, C)
    gc = jnp.cumsum(g.reshape(B, H, N, C), axis=-1)
    tri_incl = jnp.tril(jnp.ones((C, C), dtype=bool))
    tri_strict = jnp.tril(jnp.ones((C, C), dtype=bool), -1)
    diff = gc[..., :, None] - gc[..., None, :]
    decay = jnp.where(tri_incl, jnp.exp(jnp.where(tri_incl, diff, 0.0)), 0.0)
    kk = jnp.einsum('bhncd,bhnsd->bhncs', k, k)
    lmat = jnp.where(tri_strict, beta[..., :, None] * kk * decay, 0.0) + jnp.eye(C, dtype=jnp.float32)
    u = lax.linalg.triangular_solve(lmat, v * beta[..., None], left_side=True, lower=True, unit_diagonal=True)
    w = lax.linalg.triangular_solve(lmat, k * (beta * jnp.exp(gc))[..., None], left_side=True, lower=True, unit_diagonal=True)
    qk = jnp.einsum('bhncd,bhnsd->bhncs', q, k) * decay
    q_dec = q * jnp.exp(gc)[..., None]
    k_dec = k * jnp.exp(gc[..., -1:] - gc)[..., None]
    g_last = jnp.exp(gc[..., -1])

    def step(S, inp):
        u_i, w_i, qk_i, qd_i, kd_i, gl_i = inp
        v_new = u_i - jnp.einsum('bhck,bhkv->bhcv', w_i, S)
        o_i = jnp.einsum('bhck,bhkv->bhcv', qd_i, S) + jnp.einsum('bhcs,bhsv->bhcv', qk_i, v_new)
        S = S * gl_i[..., None, None] + jnp.einsum('bhck,bhcv->bhkv', kd_i, v_new)
        return S, o_i

    to_scan = lambda t: jnp.moveaxis(t, 2, 0)
    S_fin, o = lax.scan(step, S0, (to_scan(u), to_scan(w), to_scan(qk), to_scan(q_dec), to_scan(k_dec), to_scan(g_last)))
    o = jnp.moveaxis(o, 0, 2).reshape(B, H, T, dv)
    return o, S_fin


def gdn_prepare(qkv, a, b, conv_w, a_log, dt_bias, rope):
    B, T, _ = qkv.shape
    qkv = jax.nn.silu(dwconv(qkv, conv_w)).astype(jnp.float32)
    q, k, v = jnp.split(qkv, 3, axis=-1)
    heads = lambda t: t.reshape(B, T, DN_HEADS, DN_HEAD_DIM).transpose(0, 2, 1, 3)
    q = l2norm(heads(q))
    k = l2norm(heads(k))
    v = heads(v)
    if rope is not None:
        q = apply_rope(q, *rope)
        k = apply_rope(k, *rope)
    a = a.astype(jnp.float32).reshape(B, T, 2, DN_HEADS).transpose(2, 0, 3, 1)
    b = b.astype(jnp.float32).reshape(B, T, 2, DN_HEADS).transpose(2, 0, 3, 1)
    g = -jnp.exp(a_log.astype(jnp.float32))[:, None, :, None] * jax.nn.softplus(a + dt_bias.astype(jnp.float32)[:, None, :, None])
    beta = jax.nn.sigmoid(b)
    return q, k, v, g, beta


def gdn_bidir(q, k, v, g, beta, S0f, S0b):
    o_f, S_f = chunk_gated_delta(q, k, v, g[0], beta[0], S0f)
    flip = lambda t: jnp.flip(t, axis=2)
    o_b, S_b = chunk_gated_delta(flip(q), flip(k), flip(v), flip(g[1]), flip(beta[1]), S0b)
    return o_f + flip(o_b), S_f, S_b


def gdn_output(o, z, norm_g):
    B, H, T, dv = o.shape
    o = o.transpose(0, 2, 1, 3)
    o = o * lax.rsqrt(jnp.mean(o * o, axis=-1, keepdims=True) + EPS) * norm_g.astype(jnp.float32)
    o = o * jax.nn.silu(z.astype(jnp.float32)).reshape(B, T, H, dv)
    return o.reshape(B, T, H * dv).astype(z.dtype)


def short_conv(sc_in, conv_w):
    bg, cg, hh = jnp.split(sc_in, 3, axis=-1)
    return bg * dwconv(cg * hh, conv_w)


def neighbourhood_attention(q, k, v, kc, vc, rpb):
    B, T, H, dh = q.shape
    rows = T // GRID_W
    wr = min(NA_WIN_R, rows)
    to_grid = lambda t: t.reshape(B, rows, GRID_W, H, dh).transpose(0, 3, 1, 2, 4)
    qg, kg, vg = to_grid(q), to_grid(k), to_grid(v)
    ncb = GRID_W // NA_QBLK_C
    qcol = np.arange(GRID_W).reshape(ncb, NA_QBLK_C)
    kstart = np.clip(np.arange(ncb) * NA_QBLK_C - NA_WIN_C // 2, 0, GRID_W - NA_KBLK_C)
    kcol = kstart[:, None] + np.arange(NA_KBLK_C)
    cstart = np.clip(qcol - NA_WIN_C // 2, 0, GRID_W - NA_WIN_C)
    col_ok = (kcol[:, None, :] >= cstart[..., None]) & (kcol[:, None, :] < cstart[..., None] + NA_WIN_C)
    col_idx = np.clip(kcol[:, None, :] - qcol[:, :, None] + NA_WIN_C - 1, 0, 2 * NA_WIN_C - 2)
    nl = wr * NA_KBLK_C
    mask = jnp.asarray(np.broadcast_to(col_ok[:, :, None, :], (ncb, NA_QBLK_C, wr, NA_KBLK_C)).reshape(ncb, NA_QBLK_C, nl))
    rpb_c = rpb[:, :, col_idx]
    scale = dh ** -0.5

    def row_block(r):
        rs = jnp.clip(r - wr // 2, 0, rows - wr)
        kr = lax.dynamic_slice_in_dim(kg, rs, wr, axis=2)[:, :, :, kcol]
        vr = lax.dynamic_slice_in_dim(vg, rs, wr, axis=2)[:, :, :, kcol]
        kr = kr.transpose(0, 1, 3, 2, 4, 5).reshape(B, H, ncb, nl, dh)
        vr = vr.transpose(0, 1, 3, 2, 4, 5).reshape(B, H, ncb, nl, dh)
        qr = lax.dynamic_index_in_dim(qg, r, axis=2, keepdims=False).reshape(B, H, ncb, NA_QBLK_C, dh)
        ridx = rs + jnp.arange(wr) - r + NA_WIN_R - 1
        bias = rpb_c[:, ridx].transpose(0, 2, 3, 1, 4).reshape(H, ncb, NA_QBLK_C, nl).astype(jnp.float32)
        s_loc = jnp.einsum('bhnqd,bhnkd->bhnqk', qr, kr).astype(jnp.float32) * scale + bias
        s_loc = jnp.where(mask, s_loc, -1e30)
        s_ctx = jnp.einsum('bhnqd,bhcd->bhnqc', qr, kc).astype(jnp.float32) * scale
        p = jax.nn.softmax(jnp.concatenate([s_loc, s_ctx], axis=-1), axis=-1).astype(v.dtype)
        o = jnp.einsum('bhnqk,bhnkd->bhnqd', p[..., :nl], vr) + jnp.einsum('bhnqc,bhcd->bhnqd', p[..., nl:], vc)
        return o.reshape(B, H, GRID_W, dh)

    o = lax.map(row_block, jnp.arange(rows))
    return o.transpose(1, 0, 3, 2, 4).reshape(B, T, H * dh)


def context_attention(qc, kc, vc):
    B, H, L, dh = qc.shape
    s = jnp.einsum('bhqd,bhkd->bhqk', qc, kc).astype(jnp.float32) * dh ** -0.5
    p = jax.nn.softmax(s, axis=-1).astype(vc.dtype)
    return jnp.einsum('bhqk,bhkd->bhqd', p, vc).transpose(0, 2, 1, 3).reshape(B, L, H * dh)


def merge(y_a, y_b, y_c, gates, w_pa, w_pb, w_pc, w_o):
    g_a, g_b, g_c = jnp.split(jax.nn.sigmoid(gates), N_BRANCH, axis=-1)
    return (g_a * (y_a @ w_pa) + g_b * (y_b @ w_pb) + g_c * (y_c @ w_pc)) @ w_o


def token_mixing(h, hc, w_in, dn_conv_w, dn_a_log, dn_dt_bias, dn_norm_g, sc_conv_w, na_rpb, w_pa, w_pb, w_pc, w_o, rope, need_ctx):
    B, T, _ = h.shape
    L = hc.shape[1]
    qkv, z, a, b, sc_in, na_in, gates = split_cols(h @ w_in)
    qkv_c, z_c, a_c, b_c, sc_in_c, na_in_c, gates_c = split_cols(hc @ w_in)
    cq, ck, cv, cg, cb = gdn_prepare(qkv_c, a_c, b_c, dn_conv_w, dn_a_log, dn_dt_bias, None)
    S0 = jnp.zeros((B, DN_HEADS, DN_HEAD_DIM, DN_HEAD_DIM), jnp.float32)
    o_c, S_f, S_b = gdn_bidir(cq, ck, cv, cg, cb, S0, S0)
    lq, lk, lv, lg, lb = gdn_prepare(qkv, a, b, dn_conv_w, dn_a_log, dn_dt_bias, rope)
    o_l, _, _ = gdn_bidir(lq, lk, lv, lg, lb, S_f, S_b)
    y_a = gdn_output(o_l, z, dn_norm_g)
    y_b = short_conv(sc_in, sc_conv_w)
    nq, nk, nv = [t.reshape(B, T, NA_HEADS, NA_HEAD_DIM) for t in jnp.split(na_in, 3, axis=-1)]
    nqc, nkc, nvc = [t.reshape(B, L, NA_HEADS, NA_HEAD_DIM).transpose(0, 2, 1, 3) for t in jnp.split(na_in_c, 3, axis=-1)]
    y_c = neighbourhood_attention(nq, nk, nv, nkc, nvc, na_rpb)
    y = merge(y_a, y_b, y_c, gates, w_pa, w_pb, w_pc, w_o)
    if not need_ctx:
        return y, None
    yc = merge(gdn_output(o_c, z_c, dn_norm_g), short_conv(sc_in_c, sc_conv_w), context_attention(nqc, nkc, nvc), gates_c, w_pa, w_pb, w_pc, w_o)
    return y, yc


def conv_ffn(h, w_up, conv_w, conv_b, w_down):
    u = dwconv(h @ w_up, conv_w) + conv_b
    a, b = jnp.split(u, 2, axis=-1)
    return (jax.nn.silu(a) * b) @ w_down


def setup_inputs(seed: int = 0) -> dict:
    key = jax.random.key(seed)
    ks = jax.random.split(key, 24)
    f32 = jnp.float32
    nrm = lambda k, shape, s: jax.random.normal(k, shape, f32) * s
    dt = jnp.exp(jax.random.uniform(ks[11], (DEPTH, 2, DN_HEADS), f32, math.log(1e-3), math.log(1e-1)))
    return {
        'x': nrm(ks[0], (BATCH, SEQ, D_MODEL), 1.0),
        'c': nrm(ks[1], (BATCH, D_MODEL), 1.0),
        'ctx': nrm(ks[2], (BATCH, CTX_LEN, D_MODEL), 1.0),
        'c_ctx': nrm(ks[3], (D_MODEL,), 1.0),
        'norm1_g': 1.0 + nrm(ks[4], (DEPTH, D_MODEL), 0.02),
        'norm2_g': 1.0 + nrm(ks[5], (DEPTH, D_MODEL), 0.02),
        'w_ada': nrm(ks[6], (DEPTH, D_MODEL, 6 * D_MODEL), 0.5 * D_MODEL ** -0.5),
        'b_ada': nrm(ks[7], (DEPTH, 6 * D_MODEL), 0.01),
        'w_in': nrm(ks[8], (DEPTH, D_MODEL, N_IN), D_MODEL ** -0.5),
        'dn_conv_w': nrm(ks[9], (DEPTH, DN_CONV, 3 * DN_WIDTH), DN_CONV ** -0.5),
        'dn_a_log': jnp.log(jax.random.uniform(ks[10], (DEPTH, 2, DN_HEADS), f32, 1.0, 16.0)),
        'dn_dt_bias': dt + jnp.log(-jnp.expm1(-dt)),
        'dn_norm_g': 1.0 + nrm(ks[12], (DEPTH, DN_HEAD_DIM), 0.02),
        'sc_conv_w': nrm(ks[13], (DEPTH, SC_CONV, SC_WIDTH), SC_CONV ** -0.5),
        'na_rpb': nrm(ks[14], (DEPTH, NA_HEADS, 2 * NA_WIN_R - 1, 2 * NA_WIN_C - 1), 0.1),
        'w_pa': nrm(ks[15], (DEPTH, DN_WIDTH, D_MODEL), DN_WIDTH ** -0.5),
        'w_pb': nrm(ks[16], (DEPTH, SC_WIDTH, D_MODEL), SC_WIDTH ** -0.5),
        'w_pc': nrm(ks[17], (DEPTH, NA_WIDTH, D_MODEL), NA_WIDTH ** -0.5),
        'w_o': nrm(ks[18], (DEPTH, D_MODEL, D_MODEL), D_MODEL ** -0.5),
        'w_up': nrm(ks[19], (DEPTH, D_MODEL, 2 * D_FF), D_MODEL ** -0.5),
        'ffn_conv_w': nrm(ks[20], (DEPTH, FFN_CONV, 2 * D_FF), FFN_CONV ** -0.5),
        'ffn_conv_b': nrm(ks[21], (DEPTH, 2 * D_FF), 0.01),
        'w_down': nrm(ks[22], (DEPTH, D_FF, D_MODEL), D_FF ** -0.5),
        'final_norm_g': 1.0 + nrm(ks[23], (D_MODEL,), 0.02),
    }


def reference(x, c, ctx, c_ctx, norm1_g, norm2_g, w_ada, b_ada, w_in, dn_conv_w, dn_a_log, dn_dt_bias, dn_norm_g, sc_conv_w, na_rpb, w_pa, w_pb, w_pc, w_o, w_up, ffn_conv_w, ffn_conv_b, w_down, final_norm_g):
    T = x.shape[1]
    rope = axial_rope(T, DN_HEAD_DIM)
    xc = ctx
    for l in range(DEPTH):
        need_ctx = l < DEPTH - 1
        mod = (jax.nn.silu(c) @ w_ada[l] + b_ada[l])[:, None, :]
        mod_c = jax.nn.silu(c_ctx) @ w_ada[l] + b_ada[l]
        sh1, sc1, gt1, sh2, sc2, gt2 = jnp.split(mod, 6, axis=-1)
        sh1c, sc1c, gt1c, sh2c, sc2c, gt2c = jnp.split(mod_c, 6, axis=-1)
        h = rms_norm(x, norm1_g[l]) * (1.0 + sc1) + sh1
        hc = rms_norm(xc, norm1_g[l]) * (1.0 + sc1c) + sh1c
        y, yc = token_mixing(h, hc, w_in[l], dn_conv_w[l], dn_a_log[l], dn_dt_bias[l], dn_norm_g[l], sc_conv_w[l], na_rpb[l], w_pa[l], w_pb[l], w_pc[l], w_o[l], rope, need_ctx)
        x = x + gt1 * y
        h2 = rms_norm(x, norm2_g[l]) * (1.0 + sc2) + sh2
        x = x + gt2 * conv_ffn(h2, w_up[l], ffn_conv_w[l], ffn_conv_b[l], w_down[l])
        if need_ctx:
            xc = xc + gt1c * yc
            h2c = rms_norm(xc, norm2_g[l]) * (1.0 + sc2c) + sh2c
            xc = xc + gt2c * conv_ffn(h2c, w_up[l], ffn_conv_w[l], ffn_conv_b[l], w_down[l])
    return rms_norm(x, final_norm_g)
```

```cpp
#include <hip/hip_runtime.h>
#include <hip/hip_cooperative_groups.h>
#include <cstdio>
namespace cg = cooperative_groups;

typedef unsigned short bf16_t;
using bf16x8 = __attribute__((ext_vector_type(8))) short;
using f32x4  = __attribute__((ext_vector_type(4))) float;
using u32x4  = __attribute__((ext_vector_type(4))) unsigned;

#define DM 1024
#define NLAT 32768
#define NCTX 4096
#define NTOK 36864
#define NTHREADS 512
#define PITCH 72
#define LDS_BYTES 157696
#ifndef PROBE
#define PROBE 0
#endif

struct Params {
  const float *x, *c, *ctx, *c_ctx, *norm1_g, *norm2_g, *w_ada, *b_ada, *w_in, *dn_conv_w, *dn_a_log, *dn_dt_bias,
      *dn_norm_g, *sc_conv_w, *na_rpb, *w_pa, *w_pb, *w_pc, *w_o, *w_up, *ffn_conv_w, *ffn_conv_b, *w_down, *final_norm_g;
  float* out;
  float* mods;
  float* xc;
  bf16_t* H;
  bf16_t* WinT;
  bf16_t* QKV;
  bf16_t* Z;
  float* AB;
  bf16_t* SC;
  bf16_t* NQ;
  bf16_t* NK;
  bf16_t* NVt;
  bf16_t* O;
  bf16_t* Mb;
  bf16_t* W2;
  bf16_t* ACT;
  unsigned* bar;
  unsigned* xbar;
};

#define W2_G    0
#define W2_PA   3145728
#define W2_PB   (W2_PA + 524288)
#define W2_PC   (W2_PB + 524288)
#define W2_O    (W2_PC + 524288)
#define W2_UP   (W2_O + 1048576)
#define W2_DOWN (W2_UP + 5767168)

typedef __bf16 hbf16x2_t __attribute__((ext_vector_type(2)));
typedef float f32x2_t __attribute__((ext_vector_type(2)));
__device__ __forceinline__ unsigned pack2(float a, float b) {
  f32x2_t f = {a, b};
  hbf16x2_t h = __builtin_convertvector(f, hbf16x2_t);
  return __builtin_bit_cast(unsigned, h);
}
__device__ __forceinline__ bf16_t f2bf(float f) { return (bf16_t)(pack2(f, 0.f) & 0xffffu); }
__device__ __forceinline__ float bf2f(bf16_t h) { return __uint_as_float(((unsigned)h) << 16); }
__device__ __forceinline__ float lo2f(unsigned u) { return __uint_as_float(u << 16); }
__device__ __forceinline__ float hi2f(unsigned u) { return __uint_as_float(u & 0xffff0000u); }
__device__ __forceinline__ float siluf(float x) { return x * __builtin_amdgcn_rcpf(1.f + __expf(-x)); }
__device__ __forceinline__ float sigmoidf(float x) { return __builtin_amdgcn_rcpf(1.f + __expf(-x)); }
__device__ __forceinline__ f32x4 mfma16(bf16x8 a, bf16x8 b, f32x4 c) { return __builtin_amdgcn_mfma_f32_16x16x32_bf16(a, b, c, 0, 0, 0); }

__device__ __forceinline__ int get_tid() { int t = threadIdx.x; asm volatile("" : "+v"(t)); return t; }
__device__ __forceinline__ int get_bid() { int b = blockIdx.x; asm volatile("" : "+s"(b)); return b; }
__device__ __forceinline__ float* xrow(const Params& p, int row) {
  return row < NLAT ? p.out + (size_t)row * DM : p.xc + (size_t)(row - NLAT) * DM;
}
__device__ __forceinline__ const float* inrow(const Params& p, int row) {
  return row < NLAT ? p.x + (size_t)row * DM : p.ctx + (size_t)(row - NLAT) * DM;
}
__device__ __forceinline__ int modrow(int row) { return row < NLAT ? (row >> 11) : 16; }


namespace pg8 {
#define PG8_LAS __attribute__((address_space(3)))
typedef unsigned short bf16_t;
typedef short bf16x8 __attribute__((ext_vector_type(8)));
typedef float f32x4 __attribute__((ext_vector_type(4)));
typedef unsigned u32x4 __attribute__((ext_vector_type(4)));
constexpr int BM = 256, BK = 64, HALF = 128, HTB = HALF * BK * 2  , STAGE_BYTES = 8 * HTB, NXCD = 8, WGM = 8;

__host__ __device__ __forceinline__ int lds_byte(int r, int c) { const int st = (r >> 4) * 2 + (c >> 5), rr = r & 15, cc = c & 31, ob = rr * 64 + cc * 2; return st * 1024 + (ob ^ (((ob >> 9) & 1) << 5)); }
__host__ __device__ __forceinline__ void stage_rc(int b, int& R, int& C) { const int st = b / 1024, sb = b % 1024, swz = sb ^ (((sb >> 9) & 1) << 5); R = (st >> 1) * 16 + swz / 64; C = (st & 1) * 32 + (swz % 64) / 2; }
__host__ __device__ __forceinline__ int perm32(int rho) { const int n = rho >> 4, i = rho & 15; return 8 * (i >> 2) + 4 * n + (i & 3); }

struct Unit { int pm, pn; };
struct Gemm { const bf16_t* A; const bf16_t* Bt; int M, N, K, lda; };

struct StaticOrder {
    int nM, nN, nwg, G, c;
    __host__ __device__ void init(int M, int N, int G_, int c_) { nM = M / BM; nN = N / BM; nwg = nM * nN; G = G_; c = c_; }
    __host__ __device__ bool next(int i, Unit& u) const {
        const long L = (long)i * G + c; if (L >= nwg) return false;
        int wgid = (int)L; { const int q = nwg / NXCD, r = nwg % NXCD, xcd = wgid % NXCD, off = wgid / NXCD; wgid = (xcd < r ? xcd * (q + 1) : r * (q + 1) + (xcd - r) * q) + off; }
        const int nig = WGM * nN, gid = wgid / nig, fm = gid * WGM, gsz = (nM - fm) < WGM ? (nM - fm) : WGM;
        u.pm = fm + ((wgid % nig) % gsz); u.pn = (wgid % nig) / gsz; return true;
    }
    __device__ __forceinline__ void a_ready(const Unit&) const {}
    __device__ __forceinline__ void done(const Unit&) const {}
};
template <class Epi, class Sched>
__device__ __forceinline__ void gemm_phase(PG8_LAS unsigned char* lds, const Gemm g, const Sched& S, const Epi& E) {
    const int tid = ::get_tid(), wid = __builtin_amdgcn_readfirstlane(tid >> 6), lane = tid & 63, wr = wid >> 2, wc = wid & 3, fr = lane & 15, fq = lane >> 4;
    const int K = g.K, nt = K / BK;
    unsigned voffA[2], voffB[2];
#pragma unroll
    for (int i = 0; i < 2; ++i) { int R, C; stage_rc(tid * 16 + i * 8192, R, C); const int Rb = Epi::PERM ? ((R & ~31) + perm32(R & 31)) : R;
        voffA[i] = (unsigned)(R * g.lda + C) * 2u; voffB[i] = (unsigned)(Rb * K + C) * 2u; }
    const size_t kstep = (size_t)(BK * 2);
    const size_t hstepA = (size_t)HALF * g.lda * 2, hstepB = (size_t)HALF * K * 2;
    const size_t tstepA = 2 * hstepA, tstepB = 2 * hstepB;
    const unsigned ldsw = (unsigned)wid * 1024u;
    const int aoff = lds_byte(wr * 64 + fr, fq * 8), boff = lds_byte(wc * 32 + fr, fq * 8);
#define PG8_SA(b, h) (((b) * 2 + (h)) * HTB)
#define PG8_SB(b, h) ((4 + (b) * 2 + (h)) * HTB)
#define PG8_STAGE(bufoff, gbase, voff) do { _Pragma("unroll") for (int _i = 0; _i < 2; ++_i) \
        __builtin_amdgcn_global_load_lds((const unsigned*)((const char*)(gbase) + (voff)[_i]), (PG8_LAS unsigned*)(lds + (bufoff) + ldsw + _i * 8192), 16, 0, 0); } while (0)
#define PG8_LDA(dst, b, h) do { _Pragma("unroll") for (int m = 0; m < 4; ++m) _Pragma("unroll") for (int k = 0; k < 2; ++k) dst[m][k] = *(const PG8_LAS bf16x8*)(lds + PG8_SA(b, h) + aoff + m * 2048 + k * 1024); } while (0)
#define PG8_LDB(dst, b, h) do { _Pragma("unroll") for (int n = 0; n < 2; ++n) _Pragma("unroll") for (int k = 0; k < 2; ++k) dst[n][k] = *(const PG8_LAS bf16x8*)(lds + PG8_SB(b, h) + boff + n * 2048 + k * 1024); } while (0)
#define PG8_MMA(ai, bj, At, Bt) do { __builtin_amdgcn_s_setprio(1); _Pragma("unroll") for (int m = 0; m < 4; ++m) _Pragma("unroll") for (int n = 0; n < 2; ++n) _Pragma("unroll") for (int k = 0; k < 2; ++k) \
        acc[ai][bj][m][n] = __builtin_amdgcn_mfma_f32_16x16x32_bf16(Bt[n][k], At[m][k], acc[ai][bj][m][n], 0, 0, 0); __builtin_amdgcn_s_setprio(0); } while (0)
#define PG8_WAIT_V(n) asm volatile("s_waitcnt vmcnt(" #n ")" ::: "memory")
#define PG8_WAIT_L(n) asm volatile("s_waitcnt lgkmcnt(" #n ")" ::: "memory")
#define PG8_BAR __builtin_amdgcn_s_barrier()
#define PG8_SCHED __builtin_amdgcn_sched_barrier(0)
    Unit cur, nxt; int ui = 0;
    if (!S.next(0, cur)) return;
    f32x4 acc[2][2][4][2];
#pragma unroll
    for (int a = 0; a < 2; ++a)
#pragma unroll
        for (int b = 0; b < 2; ++b)
#pragma unroll
            for (int m = 0; m < 4; ++m)
#pragma unroll
                for (int n = 0; n < 2; ++n) acc[a][b][m][n] = (f32x4){0.f, 0.f, 0.f, 0.f};
    bf16x8 At[4][2], B0[2][2], B1[2][2];
    const char* cA = (const char*)g.A + (size_t)cur.pm * tstepA; const char* cB = (const char*)g.Bt + (size_t)cur.pn * tstepB;
    S.a_ready(cur);
    PG8_STAGE(PG8_SB(0, 0), cB, voffB); PG8_STAGE(PG8_SA(0, 0), cA, voffA); PG8_STAGE(PG8_SB(0, 1), cB + hstepB, voffB); PG8_STAGE(PG8_SA(0, 1), cA + hstepA, voffA);
    if (wr == 1) PG8_BAR;
    PG8_WAIT_V(4); PG8_BAR;
    PG8_STAGE(PG8_SB(1, 0), cB + kstep, voffB); PG8_STAGE(PG8_SA(1, 0), cA + kstep, voffA); PG8_STAGE(PG8_SB(1, 1), cB + hstepB + kstep, voffB);
    PG8_WAIT_V(6); PG8_BAR;
    for (;;) {
        const bool has_next = S.next(ui + 1, nxt);
        const char* nA = has_next ? (const char*)g.A + (size_t)nxt.pm * tstepA : cA; const char* nB = has_next ? (const char*)g.Bt + (size_t)nxt.pn * tstepB : cB;
        for (int t = 0; t < nt; t += 2) {
            const bool last = (t == nt - 2);
            const char* a1 = cA + (size_t)(t + 1) * kstep;
            const char* a2 = last ? nA : cA + (size_t)(t + 2) * kstep; const char* b2 = last ? nB : cB + (size_t)(t + 2) * kstep;
            const char* a3 = a2 + kstep; const char* b3 = b2 + kstep;
            if (last && has_next) S.a_ready(nxt);
            PG8_LDB(B0, 0, 0); PG8_SCHED; PG8_LDA(At, 0, 0); PG8_STAGE(PG8_SA(1, 1), a1 + hstepA, voffA);
            PG8_WAIT_L(8); PG8_BAR; PG8_WAIT_L(0); PG8_MMA(0, 0, At, B0); PG8_BAR; PG8_SCHED;
            PG8_LDB(B1, 0, 1); PG8_STAGE(PG8_SB(0, 0), b2, voffB);
            PG8_BAR; PG8_WAIT_L(0); PG8_MMA(0, 1, At, B1); PG8_BAR;
            PG8_LDA(At, 0, 1); PG8_STAGE(PG8_SA(0, 0), a2, voffA);
            PG8_BAR; PG8_WAIT_L(0); PG8_MMA(1, 0, At, B0); PG8_BAR; PG8_SCHED;
            PG8_STAGE(PG8_SB(0, 1), b2 + hstepB, voffB);
            PG8_WAIT_V(6); PG8_BAR; PG8_MMA(1, 1, At, B1); PG8_BAR;
            PG8_LDB(B0, 1, 0); PG8_SCHED; PG8_LDA(At, 1, 0); PG8_STAGE(PG8_SA(0, 1), a2 + hstepA, voffA);
            PG8_WAIT_L(8); PG8_BAR; PG8_WAIT_L(0); PG8_MMA(0, 0, At, B0); PG8_BAR; PG8_SCHED;
            PG8_LDB(B1, 1, 1); PG8_STAGE(PG8_SB(1, 0), b3, voffB);
            PG8_BAR; PG8_WAIT_L(0); PG8_MMA(0, 1, At, B1); PG8_BAR;
            PG8_LDA(At, 1, 1); PG8_STAGE(PG8_SA(1, 0), a3, voffA);
            PG8_BAR; PG8_WAIT_L(0); PG8_MMA(1, 0, At, B0); PG8_BAR; PG8_SCHED;
            PG8_STAGE(PG8_SB(1, 1), b3 + hstepB, voffB);
            PG8_WAIT_V(6); PG8_BAR; PG8_MMA(1, 1, At, B1); PG8_BAR;
        }
        if constexpr (!Epi::AFTER_DRAIN) { E(acc, cur, wr, wc, fr, fq); S.done(cur); }
        if (!has_next) break;
#pragma unroll
        for (int a = 0; a < 2; ++a)
#pragma unroll
            for (int b = 0; b < 2; ++b)
#pragma unroll
                for (int m = 0; m < 4; ++m)
#pragma unroll
                    for (int n = 0; n < 2; ++n) acc[a][b][m][n] = (f32x4){0.f, 0.f, 0.f, 0.f};
        cur = nxt; cA = nA; cB = nB; ++ui;
    }
    PG8_WAIT_V(0);
    if (wr == 0) PG8_BAR;
    PG8_BAR;
    if constexpr (Epi::AFTER_DRAIN) { E.fused(acc, cur, wr, wc, fr, fq, lds, wid, lane); S.done(cur); }
#undef PG8_SA
#undef PG8_SB
#undef PG8_STAGE
#undef PG8_LDA
#undef PG8_LDB
#undef PG8_MMA
#undef PG8_WAIT_V
#undef PG8_WAIT_L
#undef PG8_BAR
#undef PG8_SCHED
}
}

struct EpiResid {
  static constexpr bool PERM = false, AFTER_DRAIN = false;
  const Params* pp; const float* gate_l; bool first;
  __device__ __forceinline__ void operator()(const pg8::f32x4 (&acc)[2][2][4][2], const pg8::Unit& u, int wr, int wc, int fr, int fq) const {
    const Params& p = *pp;
    const int row0 = u.pm * 256 + wr * 64 + fr, col0 = u.pn * 256 + wc * 32 + 4 * fq;
    const float* gate = gate_l + (size_t)modrow(u.pm * 256) * 6144 + col0;
    f32x4 gv[2][2];
#pragma unroll
    for (int bj = 0; bj < 2; bj++)
#pragma unroll
      for (int n = 0; n < 2; n++) gv[bj][n] = *(const f32x4*)(gate + bj * 128 + n * 16);
    f32x4 xc[2][2], xn[2][2];
    {
      const int row = row0;
      const float* sx = (first ? inrow(p, row) : (const float*)xrow(p, row)) + col0;
#pragma unroll
      for (int bj = 0; bj < 2; bj++)
#pragma unroll
        for (int n = 0; n < 2; n++) xc[bj][n] = *(const f32x4*)(sx + bj * 128 + n * 16);
    }
#pragma unroll
    for (int gidx = 0; gidx < 8; gidx++) {
      const int ai = gidx >> 2, m = gidx & 3;
      const int row = row0 + ai * 128 + m * 16;
      if (gidx < 7) {
        const int nrow = row0 + ((gidx + 1) >> 2) * 128 + ((gidx + 1) & 3) * 16;
        const float* sx = (first ? inrow(p, nrow) : (const float*)xrow(p, nrow)) + col0;
#pragma unroll
        for (int bj = 0; bj < 2; bj++)
#pragma unroll
          for (int n = 0; n < 2; n++) xn[bj][n] = *(const f32x4*)(sx + bj * 128 + n * 16);
      }
      float* d = xrow(p, row) + col0;
#pragma unroll
      for (int bj = 0; bj < 2; bj++)
#pragma unroll
        for (int n = 0; n < 2; n++) *(f32x4*)(d + bj * 128 + n * 16) = xc[bj][n] + gv[bj][n] * acc[ai][bj][m][n];
      asm volatile("" ::: "memory");
#pragma unroll
      for (int bj = 0; bj < 2; bj++)
#pragma unroll
        for (int n = 0; n < 2; n++) xc[bj][n] = xn[bj][n];
    }
  }
};

struct EpiInproj {
  static constexpr bool PERM = true, AFTER_DRAIN = false;
  const Params* pp; int pn_lo;
  __device__ __forceinline__ void operator()(const pg8::f32x4 (&acc)[2][2][4][2], const pg8::Unit& u, int, int, int, int) const {
    const Params& p = *pp;
    const int t = get_tid();
    const int wid = __builtin_amdgcn_readfirstlane(t >> 6), wr = wid >> 2, wc = wid & 3, fr = t & 15, fq = (t >> 4) & 3;
    const int pn = pn_lo + u.pn;
    const int row0 = u.pm * 256 + wr * 64 + fr, cl0 = wc * 32 + 8 * fq;
    if (pn == 8) {
      if (wc == 0 && fq < 2) {
#pragma unroll
        for (int ai = 0; ai < 2; ai++)
#pragma unroll
          for (int m = 0; m < 4; m++) {
            float* d = p.AB + (size_t)(row0 + ai * 128 + m * 16) * 16 + 8 * fq;
            *(f32x4*)d = acc[ai][0][m][0]; *(f32x4*)(d + 4) = acc[ai][0][m][1];
          }
      }
    } else if (pn >= 19) {
      const int hc0 = (pn - 19) * 256 + cl0;
#pragma unroll
      for (int ai = 0; ai < 2; ai++)
#pragma unroll
        for (int m = 0; m < 4; m++) {
          const int row = row0 + ai * 128 + m * 16;
          int b, tok;
          if (row < NLAT) { b = row >> 11; tok = row & 2047; } else { b = (row - NLAT) >> 8; tok = 2048 + ((row - NLAT) & 255); }
          bf16_t* d = p.NVt + (size_t)(b * 512 + hc0) * 2304 + tok;
#pragma unroll
          for (int bj = 0; bj < 2; bj++)
#pragma unroll
            for (int n = 0; n < 2; n++)
#pragma unroll
              for (int j = 0; j < 4; j++) d[(size_t)(bj * 128 + n * 4 + j) * 2304] = f2bf(acc[ai][bj][m][n][j]);
          asm volatile("" ::: "memory");
        }
    } else {
      bf16_t* base; int ld, cb;
      if (pn < 6) { base = p.QKV; ld = 1536; cb = pn * 256; }
      else if (pn < 8) { base = p.Z; ld = 512; cb = (pn - 6) * 256; }
      else if (pn < 15) { base = p.SC; ld = 1536; cb = (pn - 9) * 256; }
      else if (pn < 17) { base = p.NQ; ld = 512; cb = (pn - 15) * 256; }
      else { base = p.NK; ld = 512; cb = (pn - 17) * 256; }
#pragma unroll
      for (int ai = 0; ai < 2; ai++)
#pragma unroll
        for (int m = 0; m < 4; m++) {
          bf16_t* rowp = base + (size_t)(row0 + ai * 128 + m * 16) * ld + cb + cl0;
#pragma unroll
          for (int bj = 0; bj < 2; bj++) {
            const f32x4 v0 = acc[ai][bj][m][0], v1 = acc[ai][bj][m][1];
            u32x4 w; w.x = pack2(v0[0], v0[1]); w.y = pack2(v0[2], v0[3]); w.z = pack2(v1[0], v1[1]); w.w = pack2(v1[2], v1[3]);
            *(u32x4*)(rowp + bj * 128) = w;
          }
          asm volatile("" ::: "memory");
        }
    }
  }
};
__device__ __forceinline__ void phase_inproj_pg8(const Params& p, unsigned char* smem, int pn_lo, int pn_hi, int nb, int bi) {
  pg8::Gemm g; g.A = p.H; g.lda = 1024; g.Bt = p.WinT + (size_t)pn_lo * 256 * 1024; g.M = NTOK; g.N = (pn_hi - pn_lo) * 256; g.K = 1024;
  pg8::StaticOrder S; S.init(NTOK, g.N, nb, bi);
  EpiInproj E; E.pp = &p; E.pn_lo = pn_lo;
  __syncthreads();
  pg8::gemm_phase<EpiInproj, pg8::StaticOrder>((PG8_LAS unsigned char*)smem, g, S, E);
  __syncthreads();
}

__device__ __forceinline__ void convert_ffn(const Params& p, int l, float* smem, int start, int stride);
__device__ __forceinline__ void convert_win(const Params& p, int l, float* smem, int start, int stride);
__device__ __forceinline__ void phase_resid_pg8(const Params& p, int l, int Mrows, const bf16_t* A, int K, const bf16_t* Wt, int gate_off, unsigned char* smem, bool first, int extra) {
  pg8::Gemm g; g.A = A; g.Bt = Wt; g.M = Mrows; g.N = 1024; g.K = K; g.lda = K;
  pg8::StaticOrder S; S.init(Mrows, 1024, (int)gridDim.x, (int)blockIdx.x);
  EpiResid E; E.pp = &p; E.gate_l = p.mods + (size_t)l * 17 * 6144 + gate_off; E.first = first;
  __syncthreads();
  pg8::gemm_phase<EpiResid, pg8::StaticOrder>((PG8_LAS unsigned char*)smem, g, S, E);
  __syncthreads();
  if (extra) {
    const int G = gridDim.x, bid = get_bid();
    const int nwg = (Mrows / 256) * 4;
    int nthird = nwg - 2 * G; nthird = nthird < 0 ? 0 : (nthird > G ? G : nthird);
    if (bid >= nthird && nthird < G) {
      if (extra == 1) convert_ffn(p, l, (float*)smem, bid - nthird, G - nthird);
      else convert_win(p, l + 1, (float*)smem, bid - nthird, G - nthird);
    }
  }
}

#define XB_TMO      128
#define XB_XCNT(j)  (256  + 64 * (j))
#define XB_XSUB(j)  (1280 + 64 * (j))
#define XB_XGEN(j)  (2304 + 64 * (j))
#define XB_TOP      3328
#define XB_TOPGEN   3392
#define XCD_BAR_WORDS 3456
#define XB_SPIN_CAP (1u << 18)
#define XLAS __attribute__((address_space(3)))

__device__ __forceinline__ unsigned xb_ld(unsigned* p)              { return __hip_atomic_load(p, __ATOMIC_RELAXED, __HIP_MEMORY_SCOPE_AGENT); }
__device__ __forceinline__ unsigned xb_add(unsigned* p, unsigned v) { return __hip_atomic_fetch_add(p, v, __ATOMIC_RELAXED, __HIP_MEMORY_SCOPE_AGENT); }
__device__ __forceinline__ unsigned xb_xcc_id() { return (unsigned)__builtin_amdgcn_s_getreg((3 << 11) | 20) & 0xFu; }
#define XB_SPIN(cond, bar) do { unsigned _sp = 0; while (cond) { __builtin_amdgcn_s_sleep(1); \
    if ((++_sp & 255u) == 0u) { if (xb_ld(&(bar)[XB_TMO])) break; if (_sp > XB_SPIN_CAP) { atomicAdd(&(bar)[XB_TMO], 1u); break; } } } } while (0)

struct XcdBarrier {
    unsigned* bar; unsigned x;
    volatile XLAS unsigned* st;
};

__device__ __forceinline__ XcdBarrier xcd_barrier_post(unsigned* bar, volatile XLAS unsigned* st) {
    XcdBarrier b; b.bar = bar; b.x = xb_xcc_id(); b.st = st;
    if (threadIdx.x == 0) (void)xb_add(&bar[XB_XCNT(b.x)], 1u);
    return b;
}
__device__ __forceinline__ void xcd_barrier_complete(unsigned* bar, unsigned x, unsigned& nloc, unsigned& nx) {
    const unsigned G = gridDim.x * gridDim.y * gridDim.z;
    unsigned sum, cnt, mine, sp = 0u;
    for (;;) {
        sum = 0u; cnt = 0u; mine = 0u;
#pragma unroll
        for (unsigned j = 0; j < 16; ++j) { const unsigned c = xb_ld(&bar[XB_XCNT(j)]); sum += c; cnt += (c > 0u) ? 1u : 0u; mine = (j == x) ? c : mine; }
        if (sum == G) break;
        __builtin_amdgcn_s_sleep(1);
        if ((++sp & 255u) == 0u) { if (xb_ld(&bar[XB_TMO])) break; if (sp > XB_SPIN_CAP) { atomicAdd(&bar[XB_TMO], 1u); break; } }
    }
    nloc = mine > 0u ? mine : 1u; nx = cnt > 0u ? cnt : 1u;
}

__device__ __forceinline__ void xcd_barrier(const XcdBarrier& b) {
    asm volatile("s_waitcnt vmcnt(0)" ::: "memory");
    __syncthreads();
    if (threadIdx.x == 0) {
        unsigned* bar = b.bar;
        __builtin_amdgcn_s_waitcnt(0);
        unsigned nloc = b.st[0], nx = b.st[1];
        if (nloc == 0u) { xcd_barrier_complete(bar, b.x, nloc, nx); b.st[0] = nloc; b.st[1] = nx; }
        const unsigned old = xb_add(&bar[XB_XSUB(b.x)], 1u);
        const unsigned gen = old / nloc;
        if (old + 1u == (gen + 1u) * nloc) {
            __builtin_amdgcn_fence(__ATOMIC_RELEASE, "agent");
            asm volatile("s_waitcnt vmcnt(0)" ::: "memory");
            const unsigned og = xb_add(&bar[XB_TOP], 1u);
            const unsigned tg = og / nx;
            if (og + 1u == (tg + 1u) * nx) xb_add(&bar[XB_TOPGEN], 1u);
            else XB_SPIN(xb_ld(&bar[XB_TOPGEN]) == tg, bar);
            __builtin_amdgcn_fence(__ATOMIC_ACQUIRE, "agent");
            xb_add(&bar[XB_XGEN(b.x)], 1u);
            asm volatile("s_waitcnt vmcnt(0)" ::: "memory");
        } else {
            XB_SPIN(xb_ld(&bar[XB_XGEN(b.x)]) == gen, bar);
            __builtin_amdgcn_fence(__ATOMIC_ACQUIRE, "agent");
            asm volatile("s_waitcnt vmcnt(0)" ::: "memory");
        }
    }
    __syncthreads();
}

__device__ __forceinline__ void phase_pre(const Params& p, float* smem) {
  const int tid = get_tid();
  __syncthreads();
  for (int e = tid; e < 17 * 1024; e += NTHREADS) {
    const int b = e >> 10, k = e & 1023;
    const float v = (b < 16) ? p.c[b * 1024 + k] : p.c_ctx[k];
    smem[e] = v / (1.f + expf(-v));
  }
  float* part = smem + 17 * 1024;
  __syncthreads();
  for (int job = get_bid(); job < 4 * 48; job += gridDim.x) {
    const int l = job / 48, cgp = job % 48;
    const int cl = tid & 127, kq = tid >> 7;
    const int col = cgp * 128 + cl;
    float acc[17];
#pragma unroll
    for (int b = 0; b < 17; b++) acc[b] = 0.f;
    const float* w = p.w_ada + ((size_t)l * 1024 + kq * 256) * 6144 + col;
#pragma unroll 8
    for (int k = 0; k < 256; k++) {
      const float wv = w[(size_t)k * 6144];
#pragma unroll
      for (int b = 0; b < 17; b++) acc[b] += smem[b * 1024 + kq * 256 + k] * wv;
    }
#pragma unroll
    for (int b = 0; b < 17; b++) part[(kq * 17 + b) * 128 + cl] = acc[b];
    __syncthreads();
    for (int e = tid; e < 17 * 128; e += NTHREADS) {
      const int b = e >> 7, c2 = e & 127;
      const float v = ((part[(0 * 17 + b) * 128 + c2] + part[(1 * 17 + b) * 128 + c2]) + (part[(2 * 17 + b) * 128 + c2] + part[(3 * 17 + b) * 128 + c2])) + p.b_ada[l * 6144 + cgp * 128 + c2];
      p.mods[(size_t)(l * 17 + b) * 6144 + cgp * 128 + c2] = v;
    }
    __syncthreads();
  }
  if (get_bid() == 0 && tid < 64) p.bar[tid] = 0u;
}

__device__ __forceinline__ void phase_rows_norm(const Params& p, int l, int which, int nrows, bool first = false) {
  const int tid = get_tid(), lane = tid & 63, wave = tid >> 6;
  const float* g = (which ? p.norm2_g : p.norm1_g) + l * 1024;
  const int stride = gridDim.x * 8;
  float4 gg[4];
#pragma unroll
  for (int i = 0; i < 4; i++) gg[i] = *(const float4*)(g + i * 256 + lane * 4);
  int row = get_bid() * 8 + wave;
  float4 v[4], sh[4], sc[4];
  if (row < nrows) {
    const float* xr = first ? inrow(p, row) : (const float*)xrow(p, row);
    const float* mod = p.mods + (size_t)(l * 17 + modrow(row)) * 6144 + which * 3072;
#pragma unroll
    for (int i = 0; i < 4; i++) { v[i] = *(const float4*)(xr + i * 256 + lane * 4); sh[i] = *(const float4*)(mod + i * 256 + lane * 4); sc[i] = *(const float4*)(mod + 1024 + i * 256 + lane * 4); }
  }
  for (; row < nrows; row += stride) {
    const int nrow = row + stride;
    float4 vn[4], shn[4], scn[4];
    if (nrow < nrows) {
      const float* xr = first ? inrow(p, nrow) : (const float*)xrow(p, nrow);
      const float* mod = p.mods + (size_t)(l * 17 + modrow(nrow)) * 6144 + which * 3072;
#pragma unroll
      for (int i = 0; i < 4; i++) { vn[i] = *(const float4*)(xr + i * 256 + lane * 4); shn[i] = *(const float4*)(mod + i * 256 + lane * 4); scn[i] = *(const float4*)(mod + 1024 + i * 256 + lane * 4); }
    }
    float ss = 0.f;
#pragma unroll
    for (int i = 0; i < 4; i++) ss += v[i].x * v[i].x + v[i].y * v[i].y + v[i].z * v[i].z + v[i].w * v[i].w;
#pragma unroll
    for (int o = 32; o >= 1; o >>= 1) ss += __shfl_xor(ss, o);
    const float rstd = rsqrtf(ss * (1.f / 1024.f) + 1e-6f);
#pragma unroll
    for (int i = 0; i < 4; i++) {
      const int k = i * 256 + lane * 4;
      float h0 = (v[i].x * rstd * gg[i].x) * (1.f + sc[i].x) + sh[i].x;
      float h1 = (v[i].y * rstd * gg[i].y) * (1.f + sc[i].y) + sh[i].y;
      float h2 = (v[i].z * rstd * gg[i].z) * (1.f + sc[i].z) + sh[i].z;
      float h3 = (v[i].w * rstd * gg[i].w) * (1.f + sc[i].w) + sh[i].w;
      uint2 o; o.x = pack2(h0, h1); o.y = pack2(h2, h3);
      *(uint2*)(p.H + (size_t)row * 1024 + k) = o;
    }
#pragma unroll
    for (int i = 0; i < 4; i++) { v[i] = vn[i]; sh[i] = shn[i]; sc[i] = scn[i]; }
  }
}

__device__ __forceinline__ void phase_final_norm(const Params& p) {
  const int tid = get_tid(), lane = tid & 63, wave = tid >> 6;
  for (int row = get_bid() * 8 + wave; row < NLAT; row += gridDim.x * 8) {
    float* xr = p.out + (size_t)row * DM;
    float4 v[4];
    float ss = 0.f;
#pragma unroll
    for (int i = 0; i < 4; i++) {
      v[i] = *(const float4*)(xr + i * 256 + lane * 4);
      ss += v[i].x * v[i].x + v[i].y * v[i].y + v[i].z * v[i].z + v[i].w * v[i].w;
    }
#pragma unroll
    for (int o = 32; o >= 1; o >>= 1) ss += __shfl_xor(ss, o);
    const float rstd = rsqrtf(ss * (1.f / 1024.f) + 1e-6f);
#pragma unroll
    for (int i = 0; i < 4; i++) {
      const int k = i * 256 + lane * 4;
      float4 gg = *(const float4*)(p.final_norm_g + k);
      float4 o;
      o.x = v[i].x * rstd * gg.x; o.y = v[i].y * rstd * gg.y; o.z = v[i].z * rstd * gg.z; o.w = v[i].w * rstd * gg.w;
      *(float4*)(xr + k) = o;
    }
  }
}

__device__ __forceinline__ int colmap(int mapid, int n) {
  if (mapid == 0) { if (n < 2064) return n; if (n < 2304) return -1; return n - 240; }
  if (mapid == 1) return 5136 + n;
  if (mapid == 3) { int t = n >> 8, j = n & 255; return j < 128 ? t * 128 + j : 2816 + t * 128 + (j - 128); }
  return n;
}
__device__ __forceinline__ void convert_tile(const float* __restrict__ src, int ldn, int K, bf16_t* __restrict__ dst, int mapid, int ntile, int ktile, float* smem) {
  const int tid = get_tid();
  const int n0 = ntile * 64, k0 = ktile * 64;
  __syncthreads();
#pragma unroll
  for (int i = 0; i < 8; i++) {
    int e = tid + NTHREADS * i;
    int kk = e >> 6, nn = e & 63;
    int col = colmap(mapid, n0 + nn);
    float v = (col >= 0) ? src[(size_t)(k0 + kk) * ldn + col] : 0.f;
    smem[kk * 65 + nn] = v;
  }
  __syncthreads();
  const int nn = tid >> 3, kc = (tid & 7) * 8;
  float f[8];
#pragma unroll
  for (int j = 0; j < 8; j++) f[j] = smem[(kc + j) * 65 + nn];
  uint4 o; o.x = pack2(f[0], f[1]); o.y = pack2(f[2], f[3]); o.z = pack2(f[4], f[5]); o.w = pack2(f[6], f[7]);
  *(uint4*)(dst + (size_t)(n0 + nn) * K + k0 + kc) = o;
}

__device__ __forceinline__ void phase_convert_B(const Params& p, int l, float* smem) {
  const int T0 = 768, T1 = T0 + 128, T2 = T1 + 128, T3 = T2 + 128, T4 = T3 + 256;
  for (int t = get_bid(); t < T4; t += gridDim.x) {
    if (t < T0) convert_tile(p.w_in + (size_t)l * 1024 * 8208, 8208, 1024, p.W2 + W2_G, 1, t >> 4, t & 15, smem);
    else if (t < T1) { int u = t - T0; convert_tile(p.w_pa + (size_t)l * 512 * 1024, 1024, 512, p.W2 + W2_PA, 2, u >> 3, u & 7, smem); }
    else if (t < T2) { int u = t - T1; convert_tile(p.w_pb + (size_t)l * 512 * 1024, 1024, 512, p.W2 + W2_PB, 2, u >> 3, u & 7, smem); }
    else if (t < T3) { int u = t - T2; convert_tile(p.w_pc + (size_t)l * 512 * 1024, 1024, 512, p.W2 + W2_PC, 2, u >> 3, u & 7, smem); }
    else { int u = t - T3; convert_tile(p.w_o + (size_t)l * 1024 * 1024, 1024, 1024, p.W2 + W2_O, 2, u >> 4, u & 15, smem); }
  }
}
__device__ __forceinline__ void convert_ffn(const Params& p, int l, float* smem, int start, int stride) {
  for (int t = start; t < 1408 + 704; t += stride) {
    if (t < 1408) convert_tile(p.w_up + (size_t)l * 1024 * 5632, 5632, 1024, p.W2 + W2_UP, 3, t >> 4, t & 15, smem);
    else { int u = t - 1408; convert_tile(p.w_down + (size_t)l * 2816 * 1024, 1024, 2816, p.W2 + W2_DOWN, 2, u / 44, u % 44, smem); }
  }
}
__device__ __forceinline__ void convert_win(const Params& p, int l, float* smem, int start, int stride) {
  const float* src = p.w_in + (size_t)l * 1024 * 8208;
  for (int t = start; t < 84 * 16; t += stride) convert_tile(src, 8208, 1024, p.WinT, 0, t >> 4, t & 15, smem);
}

template <int WM, int WN, bool TR>
__device__ __forceinline__ void gemm_compute(f32x4 (&acc)[4][4], const bf16_t* sb, int aoff, int boff) {
#pragma unroll
  for (int kk = 0; kk < 2; kk++) {
    bf16x8 af[4];
#pragma unroll
    for (int i = 0; i < 4; i++) af[i] = *(const bf16x8*)(sb + aoff + i * 16 * PITCH + kk * 32);
#pragma unroll
    for (int j = 0; j < 4; j++) {
      const bf16x8 bfr = *(const bf16x8*)(sb + boff + j * 16 * PITCH + kk * 32);
#pragma unroll
      for (int i = 0; i < 4; i++) acc[i][j] = TR ? mfma16(bfr, af[i], acc[i][j]) : mfma16(af[i], bfr, acc[i][j]);
    }
  }
}

template <int WM, int WN, bool DEEP, bool TR = false, class RowPtr>
__device__ __forceinline__ void gemm_mainloop(f32x4 (&acc)[4][4], RowPtr rowptr, const bf16_t* __restrict__ Bt, int ldb, int K, bf16_t* smem) {
  constexpr int TM = WM * 64, TN = WN * 64;
  constexpr int ACH = TM / 64, BCH = TN / 64;
  constexpr int STG = (TM + TN) * PITCH;
  const int tid = get_tid(), lane = tid & 63, wave = tid >> 6, wm = wave / WN, wn = wave % WN;
  const int lrow = tid >> 3, lkc = (tid & 7) * 8;
  const bf16_t* ap[ACH];
  const bf16_t* bp[BCH];
  bool av[ACH];
#pragma unroll
  for (int i = 0; i < ACH; i++) { const bf16_t* r = rowptr(lrow + 64 * i, av[i]); ap[i] = r + lkc; }
#pragma unroll
  for (int i = 0; i < BCH; i++) bp[i] = Bt + (size_t)(lrow + 64 * i) * ldb + lkc;
  const int KT = K >> 6;
  const int aoff = (wm * 64 + (lane & 15)) * PITCH + (lane >> 4) * 8;
  const int boff = TM * PITCH + (wn * 64 + (lane & 15)) * PITCH + (lane >> 4) * 8;
  const int soff = lrow * PITCH + lkc;
#define GLOAD(RA, RB, KS)                                                                                             \
  {                                                                                                                   \
    const int k0_ = (KS) << 6;                                                                                        \
    _Pragma("unroll") for (int i = 0; i < ACH; i++) { RA[i] = *(const u32x4*)(ap[i] + k0_); if (!av[i]) RA[i] = (u32x4){0u, 0u, 0u, 0u}; } \
    _Pragma("unroll") for (int i = 0; i < BCH; i++) RB[i] = *(const u32x4*)(bp[i] + k0_);                              \
  }
#define SSTORE(RA, RB, ST)                                                                                            \
  {                                                                                                                   \
    bf16_t* sd_ = smem + (ST) * STG + soff;                                                                           \
    _Pragma("unroll") for (int i = 0; i < ACH; i++) *(u32x4*)(sd_ + 64 * i * PITCH) = RA[i];                           \
    _Pragma("unroll") for (int i = 0; i < BCH; i++) *(u32x4*)(sd_ + TM * PITCH + 64 * i * PITCH) = RB[i];              \
  }
  if (DEEP) {
    u32x4 ra0[ACH], rb0[BCH], ra1[ACH], rb1[BCH];
    GLOAD(ra0, rb0, 0);
    GLOAD(ra1, rb1, 1);
    SSTORE(ra0, rb0, 0);
    __syncthreads();
    for (int kt = 0; kt < KT; kt += 2) {
      { const int kn = (kt + 2 < KT) ? kt + 2 : KT - 1; GLOAD(ra0, rb0, kn); }
      gemm_compute<WM, WN, TR>(acc, smem, aoff, boff);
      SSTORE(ra1, rb1, 1);
      __syncthreads();
      { const int kn = (kt + 3 < KT) ? kt + 3 : KT - 1; GLOAD(ra1, rb1, kn); }
      gemm_compute<WM, WN, TR>(acc, smem + STG, aoff, boff);
      SSTORE(ra0, rb0, 0);
      __syncthreads();
    }
  } else {
    u32x4 ra[ACH], rb[BCH];
    GLOAD(ra, rb, 0);
    SSTORE(ra, rb, 0);
    __syncthreads();
    for (int kt = 0; kt < KT; kt++) {
      { const int kn = (kt + 1 < KT) ? kt + 1 : kt; GLOAD(ra, rb, kn); }
      gemm_compute<WM, WN, TR>(acc, smem + (kt & 1) * STG, aoff, boff);
      SSTORE(ra, rb, (kt + 1) & 1);
      __syncthreads();
    }
  }
#undef GLOAD
#undef SSTORE
}

__device__ __forceinline__ void zero_acc(f32x4 (&acc)[4][4]) {
#pragma unroll
  for (int i = 0; i < 4; i++)
#pragma unroll
    for (int j = 0; j < 4; j++) acc[i][j] = (f32x4){0.f, 0.f, 0.f, 0.f};
}

__device__ __forceinline__ int tile_id(int round) {
  const int G = gridDim.x;
  const int bid = get_bid();
  int perm = bid;
  if ((G & 7) == 0) perm = (bid & 7) * (G >> 3) + (bid >> 3);
  return round * G + perm;
}

__device__ __forceinline__ void sub_barrier(unsigned* cnt, unsigned n) {
  asm volatile("s_waitcnt vmcnt(0)" ::: "memory");
  __syncthreads();
  if (threadIdx.x == 0) {
    __builtin_amdgcn_fence(__ATOMIC_RELEASE, "agent");
    asm volatile("s_waitcnt vmcnt(0)" ::: "memory");
    __hip_atomic_fetch_add(cnt, 1u, __ATOMIC_RELAXED, __HIP_MEMORY_SCOPE_AGENT);
    while (__hip_atomic_load(cnt, __ATOMIC_RELAXED, __HIP_MEMORY_SCOPE_AGENT) < n) __builtin_amdgcn_s_sleep(2);
    __builtin_amdgcn_fence(__ATOMIC_ACQUIRE, "agent");
    asm volatile("s_waitcnt vmcnt(0)" ::: "memory");
  }
  __syncthreads();
}

__device__ __forceinline__ void phase_inproj(const Params& p, bf16_t* smem, int nt_lo, int nt_hi, int nb, int bi) {
  const int NT = nt_hi - nt_lo, MT = 144;
  const int lane = get_tid() & 63, wave = get_tid() >> 6, wm = wave >> 1, wn = wave & 1;
  const int perm = ((nb & 7) == 0) ? (bi & 7) * (nb >> 3) + (bi >> 3) : bi;
  for (int rnd = 0;; rnd++) {
    const int id = rnd * nb + perm;
    if (rnd * nb >= MT * NT) break;
    if (id >= MT * NT) continue;
    const int band = id / (8 * NT), w = id % (8 * NT);
    const int mt = band * 8 + (w & 7), nt = nt_lo + (w >> 3);
    const int m0 = mt * 256;
    f32x4 acc[4][4];
    zero_acc(acc);
    const bf16_t* A = p.H + (size_t)m0 * 1024;
    if (nt >= 37) {
      gemm_mainloop<4, 2, true, false>(acc, [&](int r, bool& ok) { ok = true; return A + (size_t)r * 1024; }, p.WinT + (size_t)nt * 128 * 1024, 1024, 1024, smem);
#pragma unroll
      for (int i = 0; i < 4; i++) {
        const int rowb = m0 + wm * 64 + i * 16 + (lane >> 4) * 4;
        int b, tok;
        if (rowb < NLAT) { b = rowb >> 11; tok = rowb & 2047; } else { b = (rowb - NLAT) >> 8; tok = 2048 + ((rowb - NLAT) & 255); }
#pragma unroll
        for (int j = 0; j < 4; j++) {
          const int hc = (nt - 37) * 128 + wn * 64 + j * 16 + (lane & 15);
          const f32x4 v = acc[i][j];
          uint2 o; o.x = pack2(v[0], v[1]); o.y = pack2(v[2], v[3]);
          *(uint2*)(p.NVt + (size_t)(b * 512 + hc) * 2304 + tok) = o;
        }
      }
    } else {
      gemm_mainloop<4, 2, true, true>(acc, [&](int r, bool& ok) { ok = true; return A + (size_t)r * 1024; }, p.WinT + (size_t)nt * 128 * 1024, 1024, 1024, smem);
      if (nt == 16) {
        if (wn == 0) {
#pragma unroll
          for (int i = 0; i < 4; i++) {
            const int row = m0 + wm * 64 + i * 16 + (lane & 15);
            *(f32x4*)(p.AB + (size_t)row * 16 + (lane >> 4) * 4) = acc[i][0];
          }
        }
      } else {
        bf16_t* base; int ld, cb;
        if (nt < 12) { base = p.QKV; ld = 1536; cb = nt * 128; }
        else if (nt < 16) { base = p.Z; ld = 512; cb = (nt - 12) * 128; }
        else if (nt < 29) { base = p.SC; ld = 1536; cb = (nt - 17) * 128; }
        else if (nt < 33) { base = p.NQ; ld = 512; cb = (nt - 29) * 128; }
        else { base = p.NK; ld = 512; cb = (nt - 33) * 128; }
#pragma unroll
        for (int i = 0; i < 4; i++) {
          bf16_t* rowp = base + (size_t)(m0 + wm * 64 + i * 16 + (lane & 15)) * ld + cb + wn * 64 + (lane >> 4) * 4;
#pragma unroll
          for (int j = 0; j < 4; j++) {
            const f32x4 v = acc[i][j];
            uint2 o; o.x = pack2(v[0], v[1]); o.y = pack2(v[2], v[3]);
            *(uint2*)(rowp + j * 16) = o;
          }
        }
      }
    }
  }
}

__device__ __forceinline__ void phase_merge(const Params& p, int MT, bf16_t* smem) {
  const int NT = 8;
  const int tid = get_tid();
  const int lane = tid & 63, wave = tid >> 6, wm = wave >> 1, wn = wave & 1;
  float* park = (float*)p.O + (size_t)get_bid() * 65536;
  for (int rnd = 0;; rnd++) {
    const int id = tile_id(rnd);
    if (rnd * (int)gridDim.x >= MT * NT) break;
    if (id >= MT * NT) continue;
    const int band = id / (8 * NT), w = id % (8 * NT);
    const int mt = band * 8 + (w & 7), nt = w >> 3;
    const int m0 = mt * 256, n0 = nt * 128;
#pragma unroll 1
    for (int br = 0; br < 3; br++) {
      f32x4 acc[4][4];
      zero_acc(acc);
      const bf16_t* Ay; int lda;
      if (br == 0) { Ay = p.Z; lda = 512; } else if (br == 1) { Ay = p.SC; lda = 1536; } else { Ay = p.NQ; lda = 512; }
      Ay += (size_t)m0 * lda;
      gemm_mainloop<4, 2, true, true>(acc, [&](int r, bool& ok) { ok = true; return Ay + (size_t)r * lda; }, p.W2 + W2_PA + (size_t)br * 524288 + (size_t)n0 * 512, 512, 512, smem);
      {
        f32x4* pk = (f32x4*)park + tid;
        asm volatile("" : "+v"(pk));
#pragma unroll
        for (int i = 0; i < 4; i++)
#pragma unroll
          for (int j = 0; j < 4; j++) pk[(i * 4 + j) * 512] = acc[i][j];
      }
      __builtin_amdgcn_sched_barrier(0);
      zero_acc(acc);
      const bf16_t* Ah = p.H + (size_t)m0 * 1024;
      gemm_mainloop<4, 2, true, true>(acc, [&](int r, bool& ok) { ok = true; return Ah + (size_t)r * 1024; }, p.W2 + W2_G + (size_t)(br * 1024 + n0) * 1024, 1024, 1024, smem);
      {
        f32x4* pk = (f32x4*)park + tid;
        asm volatile("" : "+v"(pk));
        int zl = 0;
        asm volatile("" : "+v"(zl));
        f32x4 yc[4], oc[4], yn[4], on[4];
#pragma unroll
        for (int j = 0; j < 4; j++) yc[j] = pk[j * 512];
        if (br > 0) {
#pragma unroll
          for (int j = 0; j < 4; j++) oc[j] = pk[8192 + j * 512];
        }
#pragma unroll
        for (int i = 0; i < 4; i++) {
          const int rowb = m0 + wm * 64 + i * 16 + (lane & 15);
          if (i < 3) {
#pragma unroll
            for (int j = 0; j < 4; j++) yn[j] = pk[((i + 1) * 4 + j) * 512];
            if (br > 0) {
#pragma unroll
              for (int j = 0; j < 4; j++) on[j] = pk[8192 + ((i + 1) * 4 + j) * 512];
            }
          }
#pragma unroll
          for (int j = 0; j < 4; j++) {
            const int off = rowb * 1024 + n0 + wn * 64 + j * 16 + (lane >> 4) * 4 + zl;
            f32x4 v;
#pragma unroll
            for (int r = 0; r < 4; r++) v[r] = sigmoidf(acc[i][j][r]) * yc[j][r];
            if (br > 0) v += oc[j];
            if (br < 2) pk[8192 + (i * 4 + j) * 512] = v;
            else {
              uint2 o; o.x = pack2(v[0], v[1]); o.y = pack2(v[2], v[3]);
              *(uint2*)(p.Mb + off) = o;
            }
          }
          __builtin_amdgcn_sched_barrier(0);
#pragma unroll
          for (int j = 0; j < 4; j++) { yc[j] = yn[j]; oc[j] = on[j]; }
        }
      }
    }
  }
}

__device__ __forceinline__ void phase_resid_gemm(const Params& p, int l, int MT, const bf16_t* Abase, int K, const bf16_t* Wt, int gate_off, bf16_t* smem, bool first = false) {
  const int NT = 8;
  const int lane = get_tid() & 63, wave = get_tid() >> 6, wm = wave >> 1, wn = wave & 1;
  for (int rnd = 0;; rnd++) {
    const int id = tile_id(rnd);
    if (rnd * (int)gridDim.x >= MT * NT) break;
    if (id >= MT * NT) continue;
    const int band = id / (8 * NT), w = id % (8 * NT);
    const int mt = band * 8 + (w & 7), nt = w >> 3;
    const int m0 = mt * 256, n0 = nt * 128;
    f32x4 acc[4][4];
    zero_acc(acc);
    const bf16_t* A = Abase + (size_t)m0 * K;
    gemm_mainloop<4, 2, true>(acc, [&](int r, bool& ok) { ok = true; return A + (size_t)r * K; }, Wt + (size_t)n0 * K, K, K, smem);
    const float* gate = p.mods + (size_t)(l * 17 + modrow(m0)) * 6144 + gate_off;
#pragma unroll
    for (int i = 0; i < 4; i++) {
      const int rowb = m0 + wm * 64 + i * 16 + (lane >> 4) * 4;
#pragma unroll
      for (int j = 0; j < 4; j++) {
        const int col = n0 + wn * 64 + j * 16 + (lane & 15);
        const float gv = gate[col];
        float* d = xrow(p, rowb) + col;
        const float* sx = first ? inrow(p, rowb) + col : (const float*)d;
#pragma unroll
        for (int r = 0; r < 4; r++) d[(size_t)r * DM] = sx[(size_t)r * DM] + gv * acc[i][j][r];
      }
    }
  }
}

__device__ __forceinline__ void phase_ffn_up(const Params& p, int l, int MT, bf16_t* smem) {
  const int NT = 22;
  const int tid = get_tid(), lane = tid & 63, wave = tid >> 6, wm = wave >> 2, wn = wave & 3;
  float* U = (float*)smem;
  constexpr int UP = 260;
  const float* cw = p.ffn_conv_w + (size_t)l * 3 * 5632;
  const float* cb = p.ffn_conv_b + (size_t)l * 5632;
  for (int rnd = 0;; rnd++) {
    const int id = tile_id(rnd);
    if (rnd * (int)gridDim.x >= MT * NT) break;
    if (id >= MT * NT) continue;
    const int band = id / (8 * NT), w = id % (8 * NT);
    const int mt = band * 8 + (w & 7), nt = w >> 3;
    int Tseq, seqrow0, ti;
    if (mt < 272) { int b = mt / 17; ti = mt % 17; Tseq = 2048; seqrow0 = b * 2048; }
    else { int u = mt - 272; int b = u / 3; ti = u % 3; Tseq = 256; seqrow0 = NLAT + b * 256; }
    const int tstart = 126 * ti - 1;
    const int ca = nt * 128 + 2 * (tid & 63), cbn = 2816 + nt * 128 + 2 * (tid & 63);
    const f32x2_t wa0 = *(const f32x2_t*)(cw + ca), wa1 = *(const f32x2_t*)(cw + 5632 + ca), wa2 = *(const f32x2_t*)(cw + 2 * 5632 + ca), ba = *(const f32x2_t*)(cb + ca);
    const f32x2_t wb0 = *(const f32x2_t*)(cw + cbn), wb1 = *(const f32x2_t*)(cw + 5632 + cbn), wb2 = *(const f32x2_t*)(cw + 2 * 5632 + cbn), bb = *(const f32x2_t*)(cb + cbn);
    f32x4 acc[4][4];
    zero_acc(acc);
    const bf16_t* Hb = p.H;
    gemm_mainloop<2, 4, true, true>(acc, [&](int r, bool& ok) -> const bf16_t* { int t = tstart + r; ok = (t >= 0 && t < Tseq); int tc = ok ? t : 0; return Hb + (size_t)(seqrow0 + tc) * 1024; },
                        p.W2 + W2_UP + (size_t)nt * 256 * 1024, 1024, 1024, smem);
#pragma unroll
    for (int i = 0; i < 4; i++)
#pragma unroll
      for (int j = 0; j < 4; j++)
        *(f32x4*)(U + (wm * 64 + i * 16 + (lane & 15)) * UP + wn * 64 + j * 16 + (lane >> 4) * 4) = acc[i][j];
    __syncthreads();
    {
      const int cp = tid & 63, strip = tid >> 6;
      const int r0 = 1 + strip * 16;
      const int r1 = (strip == 7) ? 127 : r0 + 16;
      const float* Ua = U + 2 * cp;
      f32x2_t ua_m = *(const f32x2_t*)(Ua + (r0 - 1) * UP), ua_c = *(const f32x2_t*)(Ua + r0 * UP);
      f32x2_t ub_m = *(const f32x2_t*)(Ua + (r0 - 1) * UP + 128), ub_c = *(const f32x2_t*)(Ua + r0 * UP + 128);
      for (int rr = r0; rr < r1; rr++) {
        const f32x2_t ua_p = *(const f32x2_t*)(Ua + (rr + 1) * UP), ub_p = *(const f32x2_t*)(Ua + (rr + 1) * UP + 128);
        const int t = tstart + rr;
        if (t < Tseq) {
          const f32x2_t ua = wa0 * ua_m + wa1 * ua_c + wa2 * ua_p + ba;
          const f32x2_t ub = wb0 * ub_m + wb1 * ub_c + wb2 * ub_p + bb;
          const float o0 = siluf(ua[0]) * ub[0], o1 = siluf(ua[1]) * ub[1];
          *(unsigned*)(p.ACT + (size_t)(seqrow0 + t) * 2816 + nt * 128 + 2 * cp) = pack2(o0, o1);
        }
        ua_m = ua_c; ua_c = ua_p; ub_m = ub_c; ub_c = ub_p;
      }
    }
    __syncthreads();
  }
}

#define GP 136
__device__ __forceinline__ void gdn_chain(const Params& p, int l, int chain, unsigned char* smem_raw) {
  const int tid0 = get_tid();
  const int b = chain >> 3, h = (chain >> 1) & 3, dir = chain & 1;
  bf16_t* KQ  = (bf16_t*)smem_raw;
  bf16_t* Vs  = KQ + 128 * GP;
  bf16_t* VnT = Vs;
  bf16_t* QKm = Vs + 9216;
  bf16_t* Ut  = QKm + 4608;
  bf16_t* KdT = Ut + 9216;
  bf16_t* St  = KdT + 9216;
  float*  Lm  = (float*)(St + 128 * GP);
  float*  gcs = Lm + 64 * 68;
  float*  bts = gcs + 64;
  float*  egc = bts + 64;
  float*  cw_s = egc + 64;

  f32x4 Sreg[8];
#pragma unroll
  for (int i = 0; i < 8; i++) Sreg[i] = (f32x4){0.f, 0.f, 0.f, 0.f};
  __syncthreads();
  for (int e = tid0; e < 128 * GP / 8; e += NTHREADS) ((uint4*)St)[e] = make_uint4(0, 0, 0, 0);
  const float negA = -expf(p.dn_a_log[l * 8 + dir * 4 + h]);
  const float dtb = p.dn_dt_bias[l * 8 + dir * 4 + h];
  const float* cw = p.dn_conv_w + (size_t)l * 3 * 1536;
  bf16_t* Obase = p.O + (size_t)dir * NTOK * 512;

  for (int e = tid0; e < 9 * 128; e += NTHREADS) {
    const int ip = e >> 7, cc = e & 127;
    cw_s[e] = cw[(ip / 3) * 1536 + (ip % 3) * 512 + h * 128 + cc];
  }
  u32x4 pre[12];
#define GDN_PREFETCH(STEP, TID)                                                                               \
  {                                                                                                           \
    const bool ic_ = (STEP) < 4;                                                                              \
    const int n_ = ic_ ? (STEP) : (STEP) - 4, T_ = ic_ ? 256 : 2048, rb_ = ic_ ? NLAT + b * 256 : b * 2048;   \
    const int s_ = n_ * 64 + ((TID) >> 3);                                                                    \
    const int t_ = dir ? (T_ - 1 - s_) : s_;                                                                  \
    _Pragma("unroll") for (int part_ = 0; part_ < 2; part_++)                                                 \
      _Pragma("unroll") for (int i_ = 0; i_ < 3; i_++) {                                                      \
        const int tt_ = t_ + i_ - 1;                                                                          \
        const int ttc_ = (tt_ >= 0 && tt_ < T_) ? tt_ : t_;                                                   \
        const bf16_t* src_ = p.QKV + (size_t)(rb_ + ttc_) * 1536 + part_ * 512 + h * 128 + ((TID) & 7) * 16;  \
        pre[part_ * 6 + i_ * 2] = *(const u32x4*)src_; pre[part_ * 6 + i_ * 2 + 1] = *(const u32x4*)(src_ + 8); \
      }                                                                                                       \
  }
  GDN_PREFETCH(0, tid0);
  float av_pf = 0.f, bv_pf = 0.f;
  if (tid0 < 64) {
    const int t2 = dir ? (256 - 1 - tid0) : tid0;
    const float* ab = p.AB + (size_t)(NLAT + b * 256 + t2) * 16;
    av_pf = ab[dir * 4 + h]; bv_pf = ab[8 + dir * 4 + h];
  }
#pragma unroll 1
  for (int step = 0; step < 36; step++) {
    const int tid = get_tid();
    const int lane = tid & 63, wave = __builtin_amdgcn_readfirstlane(tid >> 6), g = lane >> 4, l15 = lane & 15;
    const bool isctx = step < 4;
    const int n = isctx ? step : step - 4;
    const int Tseq = isctx ? 256 : 2048;
    const int rowbase = isctx ? NLAT + b * 256 : b * 2048;
    {
      const int c = tid >> 3, cgp = tid & 7;
      const int s = n * 64 + c;
      const int t = dir ? (Tseq - 1 - s) : s;
      float cs8[8], sn8[8];
      int zl = 0;
      asm volatile("" : "+v"(zl));
      if (!isctx) {
        const float pos = (cgp < 4) ? (float)(t >> 6) : (float)(t & 63);
#pragma unroll
        for (int jj = 0; jj < 8; jj++) {
          const int f = (cgp & 3) * 8 + jj + zl;
          const float inv = exp2f(-(float)f * 0.4152410118609203f);
          const float ang = pos * inv;
          sn8[jj] = __sinf(ang); cs8[jj] = __cosf(ang);
        }
      }
      u32x4 vraw[6];
#pragma unroll
      for (int i = 0; i < 3; i++) {
        const int tt = t + i - 1;
        const int ttc = (tt >= 0 && tt < Tseq) ? tt : t;
        const bf16_t* src = p.QKV + (size_t)(rowbase + ttc) * 1536 + 1024 + h * 128 + cgp * 16;
        vraw[i * 2] = *(const u32x4*)src; vraw[i * 2 + 1] = *(const u32x4*)(src + 8);
      }
#pragma unroll
      for (int part = 0; part < 3; part++) {
        const int col0 = part * 512 + h * 128 + cgp * 16;
        float a[16];
#pragma unroll
        for (int j = 0; j < 16; j++) a[j] = 0.f;
#pragma unroll
        for (int i = 0; i < 3; i++) {
          const int tt = t + i - 1;
          const bool ok = (tt >= 0 && tt < Tseq);
          const float wsc = ok ? 1.f : 0.f;
          const u32x4 r0 = (part < 2) ? pre[(part & 1) * 6 + i * 2] : vraw[i * 2], r1 = (part < 2) ? pre[(part & 1) * 6 + i * 2 + 1] : vraw[i * 2 + 1];
          const float* wv = cw_s + (i * 3 + part) * 128 + cgp * 16 + zl;
          float4 w0 = *(const float4*)wv, w1 = *(const float4*)(wv + 4), w2 = *(const float4*)(wv + 8), w3 = *(const float4*)(wv + 12);
          w0.x *= wsc; w0.y *= wsc; w0.z *= wsc; w0.w *= wsc; w1.x *= wsc; w1.y *= wsc; w1.z *= wsc; w1.w *= wsc;
          w2.x *= wsc; w2.y *= wsc; w2.z *= wsc; w2.w *= wsc; w3.x *= wsc; w3.y *= wsc; w3.z *= wsc; w3.w *= wsc;
          a[0] += w0.x * lo2f(r0.x); a[1] += w0.y * hi2f(r0.x); a[2] += w0.z * lo2f(r0.y); a[3] += w0.w * hi2f(r0.y);
          a[4] += w1.x * lo2f(r0.z); a[5] += w1.y * hi2f(r0.z); a[6] += w1.z * lo2f(r0.w); a[7] += w1.w * hi2f(r0.w);
          a[8] += w2.x * lo2f(r1.x); a[9] += w2.y * hi2f(r1.x); a[10] += w2.z * lo2f(r1.y); a[11] += w2.w * hi2f(r1.y);
          a[12] += w3.x * lo2f(r1.z); a[13] += w3.y * hi2f(r1.z); a[14] += w3.z * lo2f(r1.w); a[15] += w3.w * hi2f(r1.w);
        }
#pragma unroll
        for (int j = 0; j < 16; j++) a[j] = a[j] * __builtin_amdgcn_rcpf(1.f + __expf(-a[j]));
        if (part < 2) {
          float ss = 0.f;
#pragma unroll
          for (int j = 0; j < 16; j++) ss += a[j] * a[j];
          ss += __shfl_xor(ss, 1); ss += __shfl_xor(ss, 2); ss += __shfl_xor(ss, 4);
          float sc = rsqrtf(ss + 1e-6f);
#pragma unroll
          for (int j = 0; j < 16; j++) a[j] *= sc;
          if (!isctx) {
#pragma unroll
            for (int jj = 0; jj < 8; jj++) {
              const float x1 = a[2 * jj], x2 = a[2 * jj + 1];
              a[2 * jj] = x1 * cs8[jj] - x2 * sn8[jj];
              a[2 * jj + 1] = x1 * sn8[jj] + x2 * cs8[jj];
            }
          }
          if (part == 0) {
#pragma unroll
            for (int j = 0; j < 16; j++) a[j] *= 0.08838834764831845f;
          }
        }
        bf16_t* dst = (part == 0) ? KQ + (64 + c) * GP + cgp * 16 : (part == 1) ? KQ + c * GP + cgp * 16 : Vs + c * GP + cgp * 16;
        uint4 o0, o1;
        o0.x = pack2(a[0], a[1]); o0.y = pack2(a[2], a[3]); o0.z = pack2(a[4], a[5]); o0.w = pack2(a[6], a[7]);
        o1.x = pack2(a[8], a[9]); o1.y = pack2(a[10], a[11]); o1.z = pack2(a[12], a[13]); o1.w = pack2(a[14], a[15]);
        *(uint4*)dst = o0; *(uint4*)(dst + 8) = o1;
      }
      if (step + 1 < 36) GDN_PREFETCH(step + 1, tid);
      if (wave == 0) {
        const int cc = tid;
        const float av = av_pf + dtb, bv = bv_pf;
        if (step + 1 < 36) {
          const int st2 = step + 1;
          const bool ic2 = st2 < 4;
          const int n2 = ic2 ? st2 : st2 - 4;
          const int T2 = ic2 ? 256 : 2048;
          const int rb2 = ic2 ? NLAT + b * 256 : b * 2048;
          const int s2 = n2 * 64 + cc;
          const int t2 = dir ? (T2 - 1 - s2) : s2;
          const float* ab = p.AB + (size_t)(rb2 + t2) * 16;
          av_pf = ab[dir * 4 + h]; bv_pf = ab[8 + dir * 4 + h];
        }
        const float sp = (av > 20.f) ? av : log1pf(expf(av));
        float gc = negA * sp;
#pragma unroll
        for (int o = 1; o < 64; o <<= 1) { float tv = __shfl_up(gc, o); if (lane >= o) gc += tv; }
        gcs[cc] = gc; bts[cc] = 1.f / (1.f + expf(-bv)); egc[cc] = expf(gc);
      }
    }
    __syncthreads();
    const float glast = gcs[63];
    {
      f32x4 acc[4];
#pragma unroll
      for (int j = 0; j < 4; j++) acc[j] = (f32x4){0.f, 0.f, 0.f, 0.f};
#pragma unroll
      for (int kk = 0; kk < 4; kk++) {
        const bf16x8 a = *(const bf16x8*)(KQ + (wave * 16 + l15) * GP + kk * 32 + g * 8);
#pragma unroll
        for (int j = 0; j < 4; j++) {
          const bf16x8 bq = *(const bf16x8*)(KQ + (j * 16 + l15) * GP + kk * 32 + g * 8);
          acc[j] = mfma16(a, bq, acc[j]);
        }
      }
#pragma unroll
      for (int j = 0; j < 4; j++)
#pragma unroll
        for (int r = 0; r < 4; r++) {
          const int i = (wave & 3) * 16 + g * 4 + r, jc = j * 16 + l15;
          const float dec = (i >= jc) ? __expf(gcs[i] - gcs[jc]) : 0.f;
          if (wave < 4) Lm[jc * 68 + i] = (i > jc) ? bts[i] * acc[j][r] * dec : 0.f;
          else QKm[i * PITCH + jc] = f2bf(acc[j][r] * dec);
        }
      const int dk = tid & 127, c0 = (tid >> 7) * 16;
      float kv[16];
#pragma unroll
      for (int jj = 0; jj < 16; jj++) kv[jj] = bf2f(KQ[(c0 + jj) * GP + dk]) * __expf(glast - gcs[c0 + jj]);
      uint4 o0, o1;
      o0.x = pack2(kv[0], kv[1]); o0.y = pack2(kv[2], kv[3]); o0.z = pack2(kv[4], kv[5]); o0.w = pack2(kv[6], kv[7]);
      o1.x = pack2(kv[8], kv[9]); o1.y = pack2(kv[10], kv[11]); o1.z = pack2(kv[12], kv[13]); o1.w = pack2(kv[14], kv[15]);
      *(uint4*)(KdT + dk * PITCH + c0) = o0; *(uint4*)(KdT + dk * PITCH + c0 + 8) = o1;
    }
    __syncthreads();
    if (wave < 4) {
      const bool isu = wave < 2;
      const int col = tid & 127;
#pragma unroll 1
      for (int I = 0; I < 4; I++) {
        f32x2_t rp[8];
#pragma unroll
        for (int m = 0; m < 8; m++) {
          const int c0 = I * 16 + 2 * m;
          if (isu) rp[m] = (f32x2_t){bts[c0] * bf2f(Vs[c0 * GP + col]), bts[c0 + 1] * bf2f(Vs[(c0 + 1) * GP + col])};
          else rp[m] = (f32x2_t){bts[c0] * egc[c0] * bf2f(KQ[c0 * GP + col]), bts[c0 + 1] * egc[c0 + 1] * bf2f(KQ[(c0 + 1) * GP + col])};
        }
#pragma unroll 1
        for (int j8 = 0; j8 < 2 * I; j8++) {
          float xj[8];
          if (isu) {
            const uint4 xv = *(const uint4*)(Ut + col * PITCH + j8 * 8);
            xj[0] = lo2f(xv.x); xj[1] = hi2f(xv.x); xj[2] = lo2f(xv.y); xj[3] = hi2f(xv.y);
            xj[4] = lo2f(xv.z); xj[5] = hi2f(xv.z); xj[6] = lo2f(xv.w); xj[7] = hi2f(xv.w);
          } else {
#pragma unroll
            for (int q = 0; q < 8; q++) xj[q] = bf2f(KQ[(j8 * 8 + q) * GP + col]);
          }
#pragma unroll
          for (int q = 0; q < 8; q++) {
            const float4* Lc = (const float4*)(Lm + (j8 * 8 + q) * 68 + I * 16);
            const float4 l0 = Lc[0], l1 = Lc[1], l2 = Lc[2], l3 = Lc[3];
            const float x = xj[q];
            rp[0] -= (f32x2_t){l0.x, l0.y} * x; rp[1] -= (f32x2_t){l0.z, l0.w} * x;
            rp[2] -= (f32x2_t){l1.x, l1.y} * x; rp[3] -= (f32x2_t){l1.z, l1.w} * x;
            rp[4] -= (f32x2_t){l2.x, l2.y} * x; rp[5] -= (f32x2_t){l2.z, l2.w} * x;
            rp[6] -= (f32x2_t){l3.x, l3.y} * x; rp[7] -= (f32x2_t){l3.z, l3.w} * x;
          }
        }
#pragma unroll
        for (int jj = 0; jj < 15; jj++) {
          const float x = rp[jj >> 1][jj & 1];
          const float* Lc = Lm + (I * 16 + jj) * 68 + I * 16;
          if ((jj & 1) == 0) rp[jj >> 1][1] -= Lc[jj + 1] * x;
#pragma unroll
          for (int m = (jj >> 1) + 1; m < 8; m++) {
            const f32x2_t lv = *(const f32x2_t*)(Lc + 2 * m);
            rp[m] -= lv * x;
          }
        }
        if (isu) {
          uint4 o0, o1;
          o0.x = pack2(rp[0][0], rp[0][1]); o0.y = pack2(rp[1][0], rp[1][1]); o0.z = pack2(rp[2][0], rp[2][1]); o0.w = pack2(rp[3][0], rp[3][1]);
          o1.x = pack2(rp[4][0], rp[4][1]); o1.y = pack2(rp[5][0], rp[5][1]); o1.z = pack2(rp[6][0], rp[6][1]); o1.w = pack2(rp[7][0], rp[7][1]);
          *(uint4*)(Ut + col * PITCH + I * 16) = o0; *(uint4*)(Ut + col * PITCH + I * 16 + 8) = o1;
        } else {
#pragma unroll
          for (int m = 0; m < 8; m++) { KQ[(I * 16 + 2 * m) * GP + col] = f2bf(rp[m][0]); KQ[(I * 16 + 2 * m + 1) * GP + col] = f2bf(rp[m][1]); }
        }
      }
    } else {
      const int tt = tid - 256;
      const int c = tt >> 2, seg = (tt & 3) * 32;
      const float e = egc[c];
      bf16_t* qp = KQ + (64 + c) * GP + seg;
#pragma unroll
      for (int q4 = 0; q4 < 4; q4++) {
        uint4 v = *(uint4*)(qp + q4 * 8);
        v.x = pack2(lo2f(v.x) * e, hi2f(v.x) * e); v.y = pack2(lo2f(v.y) * e, hi2f(v.y) * e);
        v.z = pack2(lo2f(v.z) * e, hi2f(v.z) * e); v.w = pack2(lo2f(v.w) * e, hi2f(v.w) * e);
        *(uint4*)(qp + q4 * 8) = v;
      }
    }
    __syncthreads();
    const int mt = wave & 3, nt0 = (wave >> 2) * 4;
    f32x4 ao[4];
    {
      f32x4 av[4];
#pragma unroll
      for (int j = 0; j < 4; j++) { av[j] = (f32x4){0.f, 0.f, 0.f, 0.f}; ao[j] = (f32x4){0.f, 0.f, 0.f, 0.f}; }
#pragma unroll
      for (int kk = 0; kk < 4; kk++) {
        const bf16x8 aw = *(const bf16x8*)(KQ + (mt * 16 + l15) * GP + kk * 32 + g * 8);
        const bf16x8 aq = *(const bf16x8*)(KQ + (64 + mt * 16 + l15) * GP + kk * 32 + g * 8);
#pragma unroll
        for (int j = 0; j < 4; j++) {
          const bf16x8 bs = *(const bf16x8*)(St + ((nt0 + j) * 16 + l15) * GP + kk * 32 + g * 8);
          av[j] = mfma16(aw, bs, av[j]);
          ao[j] = mfma16(aq, bs, ao[j]);
        }
      }
#pragma unroll
      for (int j = 0; j < 4; j++) {
        const int dv = (nt0 + j) * 16 + l15;
        const uint2 u4 = *(const uint2*)(Ut + dv * PITCH + mt * 16 + g * 4);
        uint2 o;
        o.x = pack2(lo2f(u4.x) - av[j][0], hi2f(u4.x) - av[j][1]);
        o.y = pack2(lo2f(u4.y) - av[j][2], hi2f(u4.y) - av[j][3]);
        *(uint2*)(VnT + dv * PITCH + mt * 16 + g * 4) = o;
      }
    }
    __syncthreads();
    {
#pragma unroll
      for (int kk = 0; kk < 2; kk++) {
        const bf16x8 a = *(const bf16x8*)(QKm + (mt * 16 + l15) * PITCH + kk * 32 + g * 8);
#pragma unroll
        for (int j = 0; j < 4; j++) {
          const bf16x8 bv = *(const bf16x8*)(VnT + ((nt0 + j) * 16 + l15) * PITCH + kk * 32 + g * 8);
          ao[j] = mfma16(a, bv, ao[j]);
        }
      }
#pragma unroll
      for (int r = 0; r < 4; r++) {
        const int c = mt * 16 + g * 4 + r;
        const int s = n * 64 + c;
        const int t = dir ? (Tseq - 1 - s) : s;
        bf16_t* od = Obase + (size_t)(rowbase + t) * 512 + h * 128 + l15;
#pragma unroll
        for (int j = 0; j < 4; j++) od[(nt0 + j) * 16] = f2bf(ao[j][r]);
      }
      const float gl = __expf(glast);
#pragma unroll
      for (int j = 0; j < 8; j++) { Sreg[j][0] *= gl; Sreg[j][1] *= gl; Sreg[j][2] *= gl; Sreg[j][3] *= gl; }
#pragma unroll
      for (int kk = 0; kk < 2; kk++) {
        const bf16x8 a = *(const bf16x8*)(KdT + (wave * 16 + l15) * PITCH + kk * 32 + g * 8);
#pragma unroll
        for (int j = 0; j < 8; j++) {
          const bf16x8 bv = *(const bf16x8*)(VnT + (j * 16 + l15) * PITCH + kk * 32 + g * 8);
          Sreg[j] = mfma16(a, bv, Sreg[j]);
        }
      }
#pragma unroll
      for (int j = 0; j < 8; j++) {
        uint2 o; o.x = pack2(Sreg[j][0], Sreg[j][1]); o.y = pack2(Sreg[j][2], Sreg[j][3]);
        *(uint2*)(St + (j * 16 + l15) * GP + wave * 16 + g * 4) = o;
      }
    }
    __syncthreads();
  }
}

__device__ __forceinline__ void na_wave_job(const Params& p, int l, int job, const float* rpb_s, bool dry = false) {
  const int lane = get_tid() & 63, g = lane >> 4, qi = lane & 15;
  const bool latent = job < 16384;
  int b, head, r = 0, n = 0, qrow;
  if (latent) { b = job >> 10; head = (job >> 7) & 7; r = (job >> 2) & 31; n = job & 3; qrow = b * 2048 + r * 64 + n * 16 + qi; }
  else { int j = job - 16384; b = j >> 7; head = (j >> 4) & 7; qrow = NLAT + b * 256 + (j & 15) * 16 + qi; }
  const bf16_t* qp = p.NQ + (size_t)qrow * 512 + head * 64 + g * 8;
  const bf16x8 qb0 = *(const bf16x8*)qp, qb1 = *(const bf16x8*)(qp + 32);
  float m = -1e30f, lsum = 0.f;
  f32x4 oacc[4];
#pragma unroll
  for (int d = 0; d < 4; d++) oacc[d] = (f32x4){0.f, 0.f, 0.f, 0.f};
  const bf16_t* vt = p.NVt + (size_t)((b * 8 + head) * 64) * 2304;
  const float* rpb = rpb_s + head * 465;
  int rs = r - 4; rs = rs < 0 ? 0 : (rs > 24 ? 24 : rs);
  int kstart = 16 * n - 8; kstart = kstart < 0 ? 0 : (kstart > 32 ? 32 : kstart);
  const int cq = n * 16 + qi;
  int cst = cq - 8; cst = cst < 0 ? 0 : (cst > 48 ? 48 : cst);
  const int nch = latent ? 16 : 8;
  bf16x8 kf[4], vf[4];
#define NA_LOAD(CH, KF, VF)                                                                                   \
  {                                                                                                           \
    const bool loc_ = latent && (CH) < 8;                                                                     \
    int krow_, tok_;                                                                                          \
    if (loc_) { tok_ = (rs + (CH)) * 64 + kstart; krow_ = b * 2048 + tok_; }                                  \
    else { const int cj_ = latent ? (CH) - 8 : (CH); tok_ = 2048 + cj_ * 32; krow_ = NLAT + b * 256 + cj_ * 32; } \
    _Pragma("unroll") for (int t_ = 0; t_ < 2; t_++) {                                                        \
      const int kap_ = 8 * (qi >> 2) + 4 * t_ + (qi & 3);                                                     \
      const bf16_t* kp_ = p.NK + (size_t)(krow_ + kap_) * 512 + head * 64 + g * 8;                            \
      KF[2 * t_] = *(const bf16x8*)kp_; KF[2 * t_ + 1] = *(const bf16x8*)(kp_ + 32);                          \
    }                                                                                                         \
    _Pragma("unroll") for (int d_ = 0; d_ < 4; d_++) VF[d_] = *(const bf16x8*)(vt + (size_t)(d_ * 16 + qi) * 2304 + tok_ + g * 8); \
  }
  int boff[8]; unsigned okm = 0u;
#pragma unroll
  for (int k = 0; k < 8; k++) {
    const int kc = kstart + 8 * g + k;
    int cidx = kc - cq + 15; cidx = cidx < 0 ? 0 : (cidx > 30 ? 30 : cidx);
    boff[k] = cidx;
    okm |= ((kc >= cst) && (kc < cst + 16)) ? (1u << k) : 0u;
  }
#define NA_CHUNK(CH, KC, VC, KN, VN)                                                                          \
  {                                                                                                           \
    const bool local = latent && (CH) < 8;                                                                    \
    { const int chn = ((CH) + 1 < nch) ? (CH) + 1 : (CH); NA_LOAD(chn, KN, VN); }                             \
    f32x4 s[2];                                                                                               \
    _Pragma("unroll") for (int t = 0; t < 2; t++) {                                                           \
      s[t] = mfma16(KC[2 * t], qb0, (f32x4){0.f, 0.f, 0.f, 0.f});                                             \
      s[t] = mfma16(KC[2 * t + 1], qb1, s[t]);                                                                \
    }                                                                                                         \
    float sc[8];                                                                                              \
    if (local) {                                                                                              \
      const float* rb = rpb + ((rs + (CH)) - r + 7) * 31;                                                     \
      _Pragma("unroll") for (int k = 0; k < 8; k++) {                                                         \
        const float v = s[k >> 2][k & 3] * 0.18033688011112042f + rb[boff[k]];                                \
        sc[k] = ((okm >> k) & 1u) ? v : -1e30f;                                                               \
      }                                                                                                       \
    } else {                                                                                                  \
      _Pragma("unroll") for (int k = 0; k < 8; k++) sc[k] = s[k >> 2][k & 3] * 0.18033688011112042f;          \
    }                                                                                                         \
    float cmax = sc[0];                                                                                       \
    _Pragma("unroll") for (int j = 1; j < 8; j++) cmax = fmaxf(cmax, sc[j]);                                  \
    cmax = fmaxf(cmax, __shfl_xor(cmax, 16));                                                                 \
    cmax = fmaxf(cmax, __shfl_xor(cmax, 32));                                                                 \
    const float mnew = fmaxf(m, cmax);                                                                        \
    float pv[8], psum = 0.f;                                                                                  \
    _Pragma("unroll") for (int j = 0; j < 8; j++) { pv[j] = __builtin_amdgcn_exp2f(sc[j] - mnew); psum += pv[j]; } \
    psum += __shfl_xor(psum, 16);                                                                             \
    psum += __shfl_xor(psum, 32);                                                                             \
    if (__ballot(mnew != m)) {                                                                                \
      const float alpha = __builtin_amdgcn_exp2f(m - mnew);                                                   \
      lsum *= alpha;                                                                                          \
      _Pragma("unroll") for (int d = 0; d < 4; d++) { oacc[d][0] *= alpha; oacc[d][1] *= alpha; oacc[d][2] *= alpha; oacc[d][3] *= alpha; } \
      m = mnew;                                                                                               \
    }                                                                                                         \
    lsum += psum;                                                                                             \
    union { uint4 u; bf16x8 v; } pb;                                                                          \
    pb.u.x = pack2(pv[0], pv[1]); pb.u.y = pack2(pv[2], pv[3]); pb.u.z = pack2(pv[4], pv[5]); pb.u.w = pack2(pv[6], pv[7]); \
    _Pragma("unroll") for (int d = 0; d < 4; d++) oacc[d] = mfma16(VC[d], pb.v, oacc[d]);                     \
  }
  bf16x8 kn[4], vn[4];
  NA_LOAD(0, kf, vf);
#pragma unroll 1
  for (int ch = 0; ch < nch; ch += 2) {
    NA_CHUNK(ch, kf, vf, kn, vn);
    NA_CHUNK(ch + 1, kn, vn, kf, vf);
  }
#undef NA_CHUNK
#undef NA_LOAD
  if (dry && lsum >= 0.f) return;
  const float inv = 1.f / lsum;
  bf16_t* od = p.NQ + (size_t)qrow * 512 + head * 64 + g * 4;
#pragma unroll
  for (int d = 0; d < 4; d++) {
    uint2 o; o.x = pack2(oacc[d][0] * inv, oacc[d][1] * inv); o.y = pack2(oacc[d][2] * inv, oacc[d][3] * inv);
    *(uint2*)(od + d * 16) = o;
  }
}

__device__ __forceinline__ void shortconv_items(const Params& p, int l, int nrows, int start, int stride) {
  const float* w = p.sc_conv_w + (size_t)l * 3 * 512;
  for (int item = start; item < nrows * 64; item += stride) {
    const int row = item >> 6, c8 = (item & 63) * 8;
    int t, Tseq;
    if (row < NLAT) { t = row & 2047; Tseq = 2048; } else { t = (row - NLAT) & 255; Tseq = 256; }
    float a[8];
#pragma unroll
    for (int j = 0; j < 8; j++) a[j] = 0.f;
#pragma unroll
    for (int i = 0; i < 3; i++) {
      const int tt = t + i - 1;
      if (tt >= 0 && tt < Tseq) {
        const bf16_t* src = p.SC + (size_t)(row + i - 1) * 1536 + c8;
        const uint4 cv = *(const uint4*)(src + 512), hv = *(const uint4*)(src + 1024);
        const float4 w0 = *(const float4*)(w + i * 512 + c8), w1 = *(const float4*)(w + i * 512 + c8 + 4);
        a[0] += w0.x * lo2f(cv.x) * lo2f(hv.x); a[1] += w0.y * hi2f(cv.x) * hi2f(hv.x);
        a[2] += w0.z * lo2f(cv.y) * lo2f(hv.y); a[3] += w0.w * hi2f(cv.y) * hi2f(hv.y);
        a[4] += w1.x * lo2f(cv.z) * lo2f(hv.z); a[5] += w1.y * hi2f(cv.z) * hi2f(hv.z);
        a[6] += w1.z * lo2f(cv.w) * lo2f(hv.w); a[7] += w1.w * hi2f(cv.w) * hi2f(hv.w);
      }
    }
    bf16_t* bp = p.SC + (size_t)row * 1536 + c8;
    const uint4 bv = *(const uint4*)bp;
    uint4 o;
    o.x = pack2(lo2f(bv.x) * a[0], hi2f(bv.x) * a[1]); o.y = pack2(lo2f(bv.y) * a[2], hi2f(bv.y) * a[3]);
    o.z = pack2(lo2f(bv.z) * a[4], hi2f(bv.z) * a[5]); o.w = pack2(lo2f(bv.w) * a[6], hi2f(bv.w) * a[7]);
    *(uint4*)bp = o;
  }
}

__device__ __forceinline__ void phase_mixers(const Params& p, int l, unsigned char* smem) {
  const int G = gridDim.x;
  const int nG = (G >= 256) ? 128 : (G / 2 > 0 ? G / 2 : 1);
  if (get_bid() < nG) {
    for (int chain = get_bid(); chain < 128; chain += nG) gdn_chain(p, l, chain, smem);
#if PROBE == 2
    for (int chain = get_bid(); chain < 128; chain += nG) gdn_chain(p, l, chain, smem);
#endif
  } else {
    const int nb = G - nG, bi = get_bid() - nG;
    phase_inproj_pg8(p, smem, 10, 21, nb, bi);
    sub_barrier(p.bar + l, (unsigned)nb);
    float* rpb_s = (float*)smem;
    for (int e = get_tid(); e < 8 * 465; e += NTHREADS) rpb_s[e] = p.na_rpb[(size_t)l * 8 * 465 + e] * 1.4426950408889634f;
    __syncthreads();
    const int wave = get_tid() >> 6;
    const int njobs = (l == 3) ? 16384 : 18432;
#if PROBE == 5
    for (int job = bi * 8 + wave; job < njobs; job += nb * 8) na_wave_job(p, l, job, rpb_s, true);
#endif
    for (int job = bi * 8 + wave; job < njobs; job += nb * 8) na_wave_job(p, l, job, rpb_s);
    const int nrows = (l == 3) ? NLAT : NTOK;
    shortconv_items(p, l, nrows, bi * NTHREADS + get_tid(), nb * NTHREADS);
  }
}

__device__ __forceinline__ void phase_gdn_final(const Params& p, int l, int nrows) {
  const int tid = get_tid(), lane = tid & 63, wave = tid >> 6;
  const float* ng = p.dn_norm_g + l * 128;
  const int col = lane * 8;
  const float4 g0 = *(const float4*)(ng + (col & 127)), g1 = *(const float4*)(ng + (col & 127) + 4);
  const int stride = gridDim.x * 8;
  int row = get_bid() * 8 + wave;
  uint4 of, ob, zv;
  if (row < nrows) {
    of = *(const uint4*)(p.O + (size_t)row * 512 + col);
    ob = *(const uint4*)(p.O + (size_t)NTOK * 512 + (size_t)row * 512 + col);
    zv = *(const uint4*)(p.Z + (size_t)row * 512 + col);
  }
  for (; row < nrows; row += stride) {
    const int nrow = row + stride;
    uint4 ofn, obn, zvn;
    if (nrow < nrows) {
      ofn = *(const uint4*)(p.O + (size_t)nrow * 512 + col);
      obn = *(const uint4*)(p.O + (size_t)NTOK * 512 + (size_t)nrow * 512 + col);
      zvn = *(const uint4*)(p.Z + (size_t)nrow * 512 + col);
    }
    float o[8];
    o[0] = lo2f(of.x) + lo2f(ob.x); o[1] = hi2f(of.x) + hi2f(ob.x); o[2] = lo2f(of.y) + lo2f(ob.y); o[3] = hi2f(of.y) + hi2f(ob.y);
    o[4] = lo2f(of.z) + lo2f(ob.z); o[5] = hi2f(of.z) + hi2f(ob.z); o[6] = lo2f(of.w) + lo2f(ob.w); o[7] = hi2f(of.w) + hi2f(ob.w);
    float ss = 0.f;
#pragma unroll
    for (int j = 0; j < 8; j++) ss += o[j] * o[j];
    ss += __shfl_xor(ss, 1); ss += __shfl_xor(ss, 2); ss += __shfl_xor(ss, 4); ss += __shfl_xor(ss, 8);
    const float rstd = rsqrtf(ss * (1.f / 128.f) + 1e-6f);
    float y[8];
    y[0] = o[0] * rstd * g0.x * siluf(lo2f(zv.x)); y[1] = o[1] * rstd * g0.y * siluf(hi2f(zv.x));
    y[2] = o[2] * rstd * g0.z * siluf(lo2f(zv.y)); y[3] = o[3] * rstd * g0.w * siluf(hi2f(zv.y));
    y[4] = o[4] * rstd * g1.x * siluf(lo2f(zv.z)); y[5] = o[5] * rstd * g1.y * siluf(hi2f(zv.z));
    y[6] = o[6] * rstd * g1.z * siluf(lo2f(zv.w)); y[7] = o[7] * rstd * g1.w * siluf(hi2f(zv.w));
    uint4 ov; ov.x = pack2(y[0], y[1]); ov.y = pack2(y[2], y[3]); ov.z = pack2(y[4], y[5]); ov.w = pack2(y[6], y[7]);
    *(uint4*)(p.Z + (size_t)row * 512 + col) = ov;
    of = ofn; ob = obn; zv = zvn;
  }
}

__global__ void __launch_bounds__(NTHREADS) fwd_megakernel(Params p) {
  extern __shared__ __attribute__((aligned(16))) unsigned char smem[];
  cg::grid_group grid = cg::this_grid();
  volatile XLAS unsigned* xst = (volatile XLAS unsigned*)(smem + LDS_BYTES - 16);
  if (threadIdx.x == 0) { xst[0] = 0u; xst[1] = 0u; }
  __syncthreads();
  XcdBarrier xb = xcd_barrier_post(p.xbar, xst);
  phase_pre(p, (float*)smem);
  grid.sync();
#pragma unroll 1
  for (int l = 0; l < 4; l++) {
    const bool last = (l == 3);
    phase_rows_norm(p, l, 0, NTOK, l == 0);
    if (l == 0) convert_win(p, 0, (float*)smem, get_bid(), gridDim.x);
    xcd_barrier(xb);
    phase_inproj_pg8(p, smem, 0, 10, gridDim.x, get_bid());
    xcd_barrier(xb);
    phase_mixers(p, l, smem);
    xcd_barrier(xb);
    phase_gdn_final(p, l, last ? NLAT : NTOK);
    phase_convert_B(p, l, (float*)smem);
    xcd_barrier(xb);
    phase_merge(p, last ? 128 : 144, (bf16_t*)smem);
#if PROBE == 3
    xcd_barrier(xb); phase_merge(p, last ? 128 : 144, (bf16_t*)smem);
#endif
    xcd_barrier(xb);
    phase_resid_pg8(p, l, last ? NLAT : NTOK, p.Mb, 1024, p.W2 + W2_O, 2048, smem, l == 0, 1);
    xcd_barrier(xb);
    phase_rows_norm(p, l, 1, last ? NLAT : NTOK);
    xcd_barrier(xb);
    phase_ffn_up(p, l, last ? 272 : 320, (bf16_t*)smem);
#if PROBE == 4
    xcd_barrier(xb); phase_ffn_up(p, l, last ? 272 : 320, (bf16_t*)smem);
#endif
    xcd_barrier(xb);
    phase_resid_pg8(p, l, last ? NLAT : NTOK, p.ACT, 2816, p.W2 + W2_DOWN, 5120, smem, false, last ? 0 : 2);
    xcd_barrier(xb);
  }
  phase_final_norm(p);
}

extern "C" void kernel_launch(void* const* d_in, const int* in_sizes, int n_in, void* d_out, int out_size, void* d_ws, size_t ws_size,
                              hipStream_t stream) {
  static int grid_blocks = 0;
  if (!grid_blocks) {
    int dev = 0, cus = 0, per_cu = 0;
    hipGetDevice(&dev);
    hipDeviceGetAttribute(&cus, hipDeviceAttributeMultiprocessorCount, dev);
    hipFuncSetAttribute((const void*)fwd_megakernel, hipFuncAttributeMaxDynamicSharedMemorySize, LDS_BYTES);
    hipOccupancyMaxActiveBlocksPerMultiprocessor(&per_cu, fwd_megakernel, NTHREADS, LDS_BYTES);
    if (per_cu < 1) { fprintf(stderr, "occupancy query returned %d\n", per_cu); per_cu = 1; }
    grid_blocks = cus * 1;
    (void)hipGetLastError();
  }
  Params p{};
  const float** ins = (const float**)&p;
  for (int i = 0; i < 24; i++) ins[i] = (const float*)d_in[i];
  p.out = (float*)d_out;
  unsigned char* ws = (unsigned char*)d_ws;
  size_t off = 0;
  auto take = [&](size_t bytes) { unsigned char* r = ws + off; off += (bytes + 255) & ~(size_t)255; return r; };
  p.mods = (float*)take((size_t)4 * 17 * 6144 * 4);
  p.xc = (float*)take((size_t)NCTX * DM * 4);
  p.H = (bf16_t*)take((size_t)NTOK * 1024 * 2);
  p.WinT = (bf16_t*)take((size_t)5376 * 1024 * 2);
  p.QKV = (bf16_t*)take((size_t)NTOK * 1536 * 2);
  p.Z = (bf16_t*)take((size_t)NTOK * 512 * 2);
  p.AB = (float*)take((size_t)NTOK * 16 * 4);
  p.SC = (bf16_t*)take((size_t)NTOK * 1536 * 2);
  p.NQ = (bf16_t*)take((size_t)NTOK * 512 * 2);
  p.NK = (bf16_t*)take((size_t)NTOK * 512 * 2);
  p.NVt = (bf16_t*)take((size_t)8192 * 2304 * 2);
  p.O = (bf16_t*)take((size_t)2 * NTOK * 512 * 2);
  p.Mb = p.QKV;
  p.W2 = p.QKV + (size_t)NTOK * 1024;
  p.ACT = p.SC;
  p.bar = (unsigned*)take(256);
  p.xbar = (unsigned*)take((size_t)XCD_BAR_WORDS * 4);
  if (off > ws_size) { fprintf(stderr, "workspace too small: need %zu have %zu\n", off, ws_size); return; }
  (void)hipMemsetAsync(p.xbar, 0, (size_t)XCD_BAR_WORDS * 4, stream);
  void* args[] = {&p};
  hipError_t e = hipLaunchCooperativeKernel((void*)fwd_megakernel, dim3(grid_blocks), dim3(NTHREADS), args, LDS_BYTES, stream);
  if (e != hipSuccess) fprintf(stderr, "cooperative launch failed: %s (grid %d)\n", hipGetErrorString(e), grid_blocks);
}
```

```cpp
#include <hip/hip_runtime.h>
#include <hip/hip_cooperative_groups.h>
#include <cstdio>
namespace cg = cooperative_groups;

typedef unsigned short bf16_t;
using bf16x8 = __attribute__((ext_vector_type(8))) short;
using f32x4  = __attribute__((ext_vector_type(4))) float;
using u32x4  = __attribute__((ext_vector_type(4))) unsigned;

#define DM 1024
#define NLAT 32768
#define NCTX 4096
#define NTOK 36864
#define NTHREADS 512
#define PITCH 72
#define LDS_BYTES 157696
#ifndef PROBE
#define PROBE 0
#endif

struct Params {
  const float *x, *c, *ctx, *c_ctx, *norm1_g, *norm2_g, *w_ada, *b_ada, *w_in, *dn_conv_w, *dn_a_log, *dn_dt_bias,
      *dn_norm_g, *sc_conv_w, *na_rpb, *w_pa, *w_pb, *w_pc, *w_o, *w_up, *ffn_conv_w, *ffn_conv_b, *w_down, *final_norm_g;
  float* out;
  float* mods;
  float* xc;
  bf16_t* H;
  bf16_t* WinT;
  bf16_t* QKV;
  bf16_t* Z;
  float* AB;
  bf16_t* SC;
  bf16_t* NQ;
  bf16_t* NK;
  bf16_t* NVt;
  bf16_t* O;
  bf16_t* Mb;
  bf16_t* W2;
  bf16_t* ACT;
  unsigned* bar;
  unsigned* xbar;
};

#define W2_G    0
#define W2_PA   3145728
#define W2_PB   (W2_PA + 524288)
#define W2_PC   (W2_PB + 524288)
#define W2_O    (W2_PC + 524288)
#define W2_UP   (W2_O + 1048576)
#define W2_DOWN (W2_UP + 5767168)

typedef __bf16 hbf16x2_t __attribute__((ext_vector_type(2)));
typedef float f32x2_t __attribute__((ext_vector_type(2)));
__device__ __forceinline__ unsigned pack2(float a, float b) {
  f32x2_t f = {a, b};
  hbf16x2_t h = __builtin_convertvector(f, hbf16x2_t);
  return __builtin_bit_cast(unsigned, h);
}
__device__ __forceinline__ bf16_t f2bf(float f) { return (bf16_t)(pack2(f, 0.f) & 0xffffu); }
__device__ __forceinline__ float bf2f(bf16_t h) { return __uint_as_float(((unsigned)h) << 16); }
__device__ __forceinline__ float lo2f(unsigned u) { return __uint_as_float(u << 16); }
__device__ __forceinline__ float hi2f(unsigned u) { return __uint_as_float(u & 0xffff0000u); }
__device__ __forceinline__ float siluf(float x) { return x * __builtin_amdgcn_rcpf(1.f + __expf(-x)); }
__device__ __forceinline__ float sigmoidf(float x) { return __builtin_amdgcn_rcpf(1.f + __expf(-x)); }
__device__ __forceinline__ f32x4 mfma16(bf16x8 a, bf16x8 b, f32x4 c) { return __builtin_amdgcn_mfma_f32_16x16x32_bf16(a, b, c, 0, 0, 0); }

__device__ __forceinline__ int get_tid() { int t = threadIdx.x; asm volatile("" : "+v"(t)); return t; }
__device__ __forceinline__ int get_bid() { int b = blockIdx.x; asm volatile("" : "+s"(b)); return b; }
__device__ __forceinline__ float* xrow(const Params& p, int row) {
  return row < NLAT ? p.out + (size_t)row * DM : p.xc + (size_t)(row - NLAT) * DM;
}
__device__ __forceinline__ const float* inrow(const Params& p, int row) {
  return row < NLAT ? p.x + (size_t)row * DM : p.ctx + (size_t)(row - NLAT) * DM;
}
__device__ __forceinline__ int modrow(int row) { return row < NLAT ? (row >> 11) : 16; }


namespace pg8 {
#define PG8_LAS __attribute__((address_space(3)))
typedef unsigned short bf16_t;
typedef short bf16x8 __attribute__((ext_vector_type(8)));
typedef float f32x4 __attribute__((ext_vector_type(4)));
typedef unsigned u32x4 __attribute__((ext_vector_type(4)));
constexpr int BM = 256, BK = 64, HALF = 128, HTB = HALF * BK * 2  , STAGE_BYTES = 8 * HTB, NXCD = 8, WGM = 8;

__host__ __device__ __forceinline__ int lds_byte(int r, int c) { const int st = (r >> 4) * 2 + (c >> 5), rr = r & 15, cc = c & 31, ob = rr * 64 + cc * 2; return st * 1024 + (ob ^ (((ob >> 9) & 1) << 5)); }
__host__ __device__ __forceinline__ void stage_rc(int b, int& R, int& C) { const int st = b / 1024, sb = b % 1024, swz = sb ^ (((sb >> 9) & 1) << 5); R = (st >> 1) * 16 + swz / 64; C = (st & 1) * 32 + (swz % 64) / 2; }
__host__ __device__ __forceinline__ int perm32(int rho) { const int n = rho >> 4, i = rho & 15; return 8 * (i >> 2) + 4 * n + (i & 3); }

struct Unit { int pm, pn; };
struct Gemm { const bf16_t* A; const bf16_t* Bt; int M, N, K, lda; };

struct StaticOrder {
    int nM, nN, nwg, G, c;
    __host__ __device__ void init(int M, int N, int G_, int c_) { nM = M / BM; nN = N / BM; nwg = nM * nN; G = G_; c = c_; }
    __host__ __device__ bool next(int i, Unit& u) const {
        const long L = (long)i * G + c; if (L >= nwg) return false;
        int wgid = (int)L; { const int q = nwg / NXCD, r = nwg % NXCD, xcd = wgid % NXCD, off = wgid / NXCD; wgid = (xcd < r ? xcd * (q + 1) : r * (q + 1) + (xcd - r) * q) + off; }
        const int nig = WGM * nN, gid = wgid / nig, fm = gid * WGM, gsz = (nM - fm) < WGM ? (nM - fm) : WGM;
        u.pm = fm + ((wgid % nig) % gsz); u.pn = (wgid % nig) / gsz; return true;
    }
    __device__ __forceinline__ void a_ready(const Unit&) const {}
    __device__ __forceinline__ void done(const Unit&) const {}
};
template <class Epi, class Sched>
__device__ __forceinline__ void gemm_phase(PG8_LAS unsigned char* lds, const Gemm g, const Sched& S, const Epi& E) {
    const int tid = ::get_tid(), wid = __builtin_amdgcn_readfirstlane(tid >> 6), lane = tid & 63, wr = wid >> 2, wc = wid & 3, fr = lane & 15, fq = lane >> 4;
    const int K = g.K, nt = K / BK;
    unsigned voffA[2], voffB[2];
#pragma unroll
    for (int i = 0; i < 2; ++i) { int R, C; stage_rc(tid * 16 + i * 8192, R, C); const int Rb = Epi::PERM ? ((R & ~31) + perm32(R & 31)) : R;
        voffA[i] = (unsigned)(R * g.lda + C) * 2u; voffB[i] = (unsigned)(Rb * K + C) * 2u; }
    const size_t kstep = (size_t)(BK * 2);
    const size_t hstepA = (size_t)HALF * g.lda * 2, hstepB = (size_t)HALF * K * 2;
    const size_t tstepA = 2 * hstepA, tstepB = 2 * hstepB;
    const unsigned ldsw = (unsigned)wid * 1024u;
    const int aoff = lds_byte(wr * 64 + fr, fq * 8), boff = lds_byte(wc * 32 + fr, fq * 8);
#define PG8_SA(b, h) (((b) * 2 + (h)) * HTB)
#define PG8_SB(b, h) ((4 + (b) * 2 + (h)) * HTB)
#define PG8_STAGE(bufoff, gbase, voff) do { _Pragma("unroll") for (int _i = 0; _i < 2; ++_i) \
        __builtin_amdgcn_global_load_lds((const unsigned*)((const char*)(gbase) + (voff)[_i]), (PG8_LAS unsigned*)(lds + (bufoff) + ldsw + _i * 8192), 16, 0, 0); } while (0)
#define PG8_LDA(dst, b, h) do { _Pragma("unroll") for (int m = 0; m < 4; ++m) _Pragma("unroll") for (int k = 0; k < 2; ++k) dst[m][k] = *(const PG8_LAS bf16x8*)(lds + PG8_SA(b, h) + aoff + m * 2048 + k * 1024); } while (0)
#define PG8_LDB(dst, b, h) do { _Pragma("unroll") for (int n = 0; n < 2; ++n) _Pragma("unroll") for (int k = 0; k < 2; ++k) dst[n][k] = *(const PG8_LAS bf16x8*)(lds + PG8_SB(b, h) + boff + n * 2048 + k * 1024); } while (0)
#define PG8_MMA(ai, bj, At, Bt) do { __builtin_amdgcn_s_setprio(1); _Pragma("unroll") for (int m = 0; m < 4; ++m) _Pragma("unroll") for (int n = 0; n < 2; ++n) _Pragma("unroll") for (int k = 0; k < 2; ++k) \
        acc[ai][bj][m][n] = __builtin_amdgcn_mfma_f32_16x16x32_bf16(Bt[n][k], At[m][k], acc[ai][bj][m][n], 0, 0, 0); __builtin_amdgcn_s_setprio(0); } while (0)
#define PG8_WAIT_V(n) asm volatile("s_waitcnt vmcnt(" #n ")" ::: "memory")
#define PG8_WAIT_L(n) asm volatile("s_waitcnt lgkmcnt(" #n ")" ::: "memory")
#define PG8_BAR __builtin_amdgcn_s_barrier()
#define PG8_SCHED __builtin_amdgcn_sched_barrier(0)
    Unit cur, nxt; int ui = 0;
    if (!S.next(0, cur)) return;
    f32x4 acc[2][2][4][2];
#pragma unroll
    for (int a = 0; a < 2; ++a)
#pragma unroll
        for (int b = 0; b < 2; ++b)
#pragma unroll
            for (int m = 0; m < 4; ++m)
#pragma unroll
                for (int n = 0; n < 2; ++n) acc[a][b][m][n] = (f32x4){0.f, 0.f, 0.f, 0.f};
    bf16x8 At[4][2], B0[2][2], B1[2][2];
    const char* cA = (const char*)g.A + (size_t)cur.pm * tstepA; const char* cB = (const char*)g.Bt + (size_t)cur.pn * tstepB;
    S.a_ready(cur);
    PG8_STAGE(PG8_SB(0, 0), cB, voffB); PG8_STAGE(PG8_SA(0, 0), cA, voffA); PG8_STAGE(PG8_SB(0, 1), cB + hstepB, voffB); PG8_STAGE(PG8_SA(0, 1), cA + hstepA, voffA);
    if (wr == 1) PG8_BAR;
    PG8_WAIT_V(4); PG8_BAR;
    PG8_STAGE(PG8_SB(1, 0), cB + kstep, voffB); PG8_STAGE(PG8_SA(1, 0), cA + kstep, voffA); PG8_STAGE(PG8_SB(1, 1), cB + hstepB + kstep, voffB);
    PG8_WAIT_V(6); PG8_BAR;
    for (;;) {
        const bool has_next = S.next(ui + 1, nxt);
        const char* nA = has_next ? (const char*)g.A + (size_t)nxt.pm * tstepA : cA; const char* nB = has_next ? (const char*)g.Bt + (size_t)nxt.pn * tstepB : cB;
        for (int t = 0; t < nt; t += 2) {
            const bool last = (t == nt - 2);
            const char* a1 = cA + (size_t)(t + 1) * kstep;
            const char* a2 = last ? nA : cA + (size_t)(t + 2) * kstep; const char* b2 = last ? nB : cB + (size_t)(t + 2) * kstep;
            const char* a3 = a2 + kstep; const char* b3 = b2 + kstep;
            if (last && has_next) S.a_ready(nxt);
            PG8_LDB(B0, 0, 0); PG8_SCHED; PG8_LDA(At, 0, 0); PG8_STAGE(PG8_SA(1, 1), a1 + hstepA, voffA);
            PG8_WAIT_L(8); PG8_BAR; PG8_WAIT_L(0); PG8_MMA(0, 0, At, B0); PG8_BAR; PG8_SCHED;
            PG8_LDB(B1, 0, 1); PG8_STAGE(PG8_SB(0, 0), b2, voffB);
            PG8_BAR; PG8_WAIT_L(0); PG8_MMA(0, 1, At, B1); PG8_BAR;
            PG8_LDA(At, 0, 1); PG8_STAGE(PG8_SA(0, 0), a2, voffA);
            PG8_BAR; PG8_WAIT_L(0); PG8_MMA(1, 0, At, B0); PG8_BAR; PG8_SCHED;
            PG8_STAGE(PG8_SB(0, 1), b2 + hstepB, voffB);
            PG8_WAIT_V(6); PG8_BAR; PG8_MMA(1, 1, At, B1); PG8_BAR;
            PG8_LDB(B0, 1, 0); PG8_SCHED; PG8_LDA(At, 1, 0); PG8_STAGE(PG8_SA(0, 1), a2 + hstepA, voffA);
            PG8_WAIT_L(8); PG8_BAR; PG8_WAIT_L(0); PG8_MMA(0, 0, At, B0); PG8_BAR; PG8_SCHED;
            PG8_LDB(B1, 1, 1); PG8_STAGE(PG8_SB(1, 0), b3, voffB);
            PG8_BAR; PG8_WAIT_L(0); PG8_MMA(0, 1, At, B1); PG8_BAR;
            PG8_LDA(At, 1, 1); PG8_STAGE(PG8_SA(1, 0), a3, voffA);
            PG8_BAR; PG8_WAIT_L(0); PG8_MMA(1, 0, At, B0); PG8_BAR; PG8_SCHED;
            PG8_STAGE(PG8_SB(1, 1), b3 + hstepB, voffB);
            PG8_WAIT_V(6); PG8_BAR; PG8_MMA(1, 1, At, B1); PG8_BAR;
        }
        if constexpr (!Epi::AFTER_DRAIN) { E(acc, cur, wr, wc, fr, fq); S.done(cur); }
        if (!has_next) break;
#pragma unroll
        for (int a = 0; a < 2; ++a)
#pragma unroll
            for (int b = 0; b < 2; ++b)
#pragma unroll
                for (int m = 0; m < 4; ++m)
#pragma unroll
                    for (int n = 0; n < 2; ++n) acc[a][b][m][n] = (f32x4){0.f, 0.f, 0.f, 0.f};
        cur = nxt; cA = nA; cB = nB; ++ui;
    }
    PG8_WAIT_V(0);
    if (wr == 0) PG8_BAR;
    PG8_BAR;
    if constexpr (Epi::AFTER_DRAIN) { E.fused(acc, cur, wr, wc, fr, fq, lds, wid, lane); S.done(cur); }
#undef PG8_SA
#undef PG8_SB
#undef PG8_STAGE
#undef PG8_LDA
#undef PG8_LDB
#undef PG8_MMA
#undef PG8_WAIT_V
#undef PG8_WAIT_L
#undef PG8_BAR
#undef PG8_SCHED
}
}

struct EpiResid {
  static constexpr bool PERM = false, AFTER_DRAIN = false;
  const Params* pp; const float* gate_l; bool first;
  __device__ __forceinline__ void operator()(const pg8::f32x4 (&acc)[2][2][4][2], const pg8::Unit& u, int wr, int wc, int fr, int fq) const {
    const Params& p = *pp;
    const int row0 = u.pm * 256 + wr * 64 + fr, col0 = u.pn * 256 + wc * 32 + 4 * fq;
    const float* gate = gate_l + (size_t)modrow(u.pm * 256) * 6144 + col0;
    f32x4 gv[2][2];
#pragma unroll
    for (int bj = 0; bj < 2; bj++)
#pragma unroll
      for (int n = 0; n < 2; n++) gv[bj][n] = *(const f32x4*)(gate + bj * 128 + n * 16);
    f32x4 xc[2][2], xn[2][2];
    {
      const int row = row0;
      const float* sx = (first ? inrow(p, row) : (const float*)xrow(p, row)) + col0;
#pragma unroll
      for (int bj = 0; bj < 2; bj++)
#pragma unroll
        for (int n = 0; n < 2; n++) xc[bj][n] = *(const f32x4*)(sx + bj * 128 + n * 16);
    }
#pragma unroll
    for (int gidx = 0; gidx < 8; gidx++) {
      const int ai = gidx >> 2, m = gidx & 3;
      const int row = row0 + ai * 128 + m * 16;
      if (gidx < 7) {
        const int nrow = row0 + ((gidx + 1) >> 2) * 128 + ((gidx + 1) & 3) * 16;
        const float* sx = (first ? inrow(p, nrow) : (const float*)xrow(p, nrow)) + col0;
#pragma unroll
        for (int bj = 0; bj < 2; bj++)
#pragma unroll
          for (int n = 0; n < 2; n++) xn[bj][n] = *(const f32x4*)(sx + bj * 128 + n * 16);
      }
      float* d = xrow(p, row) + col0;
#pragma unroll
      for (int bj = 0; bj < 2; bj++)
#pragma unroll
        for (int n = 0; n < 2; n++) *(f32x4*)(d + bj * 128 + n * 16) = xc[bj][n] + gv[bj][n] * acc[ai][bj][m][n];
      asm volatile("" ::: "memory");
#pragma unroll
      for (int bj = 0; bj < 2; bj++)
#pragma unroll
        for (int n = 0; n < 2; n++) xc[bj][n] = xn[bj][n];
    }
  }
};

struct EpiInproj {
  static constexpr bool PERM = true, AFTER_DRAIN = false;
  const Params* pp; int pn_lo;
  __device__ __forceinline__ void operator()(const pg8::f32x4 (&acc)[2][2][4][2], const pg8::Unit& u, int, int, int, int) const {
    const Params& p = *pp;
    const int t = get_tid();
    const int wid = __builtin_amdgcn_readfirstlane(t >> 6), wr = wid >> 2, wc = wid & 3, fr = t & 15, fq = (t >> 4) & 3;
    const int pn = pn_lo + u.pn;
    const int row0 = u.pm * 256 + wr * 64 + fr, cl0 = wc * 32 + 8 * fq;
    if (pn == 8) {
      if (wc == 0 && fq < 2) {
#pragma unroll
        for (int ai = 0; ai < 2; ai++)
#pragma unroll
          for (int m = 0; m < 4; m++) {
            float* d = p.AB + (size_t)(row0 + ai * 128 + m * 16) * 16 + 8 * fq;
            *(f32x4*)d = acc[ai][0][m][0]; *(f32x4*)(d + 4) = acc[ai][0][m][1];
          }
      }
    } else if (pn >= 19) {
      const int hc0 = (pn - 19) * 256 + cl0;
#pragma unroll
      for (int ai = 0; ai < 2; ai++)
#pragma unroll
        for (int m = 0; m < 4; m++) {
          const int row = row0 + ai * 128 + m * 16;
          int b, tok;
          if (row < NLAT) { b = row >> 11; tok = row & 2047; } else { b = (row - NLAT) >> 8; tok = 2048 + ((row - NLAT) & 255); }
          bf16_t* d = p.NVt + (size_t)(b * 512 + hc0) * 2304 + tok;
#pragma unroll
          for (int bj = 0; bj < 2; bj++)
#pragma unroll
            for (int n = 0; n < 2; n++)
#pragma unroll
              for (int j = 0; j < 4; j++) d[(size_t)(bj * 128 + n * 4 + j) * 2304] = f2bf(acc[ai][bj][m][n][j]);
          asm volatile("" ::: "memory");
        }
    } else {
      bf16_t* base; int ld, cb;
      if (pn < 6) { base = p.QKV; ld = 1536; cb = pn * 256; }
      else if (pn < 8) { base = p.Z; ld = 512; cb = (pn - 6) * 256; }
      else if (pn < 15) { base = p.SC; ld = 1536; cb = (pn - 9) * 256; }
      else if (pn < 17) { base = p.NQ; ld = 512; cb = (pn - 15) * 256; }
      else { base = p.NK; ld = 512; cb = (pn - 17) * 256; }
#pragma unroll
      for (int ai = 0; ai < 2; ai++)
#pragma unroll
        for (int m = 0; m < 4; m++) {
          bf16_t* rowp = base + (size_t)(row0 + ai * 128 + m * 16) * ld + cb + cl0;
#pragma unroll
          for (int bj = 0; bj < 2; bj++) {
            const f32x4 v0 = acc[ai][bj][m][0], v1 = acc[ai][bj][m][1];
            u32x4 w; w.x = pack2(v0[0], v0[1]); w.y = pack2(v0[2], v0[3]); w.z = pack2(v1[0], v1[1]); w.w = pack2(v1[2], v1[3]);
            *(u32x4*)(rowp + bj * 128) = w;
          }
          asm volatile("" ::: "memory");
        }
    }
  }
};
__device__ __forceinline__ void phase_inproj_pg8(const Params& p, unsigned char* smem, int pn_lo, int pn_hi, int nb, int bi) {
  pg8::Gemm g; g.A = p.H; g.lda = 1024; g.Bt = p.WinT + (size_t)pn_lo * 256 * 1024; g.M = NTOK; g.N = (pn_hi - pn_lo) * 256; g.K = 1024;
  pg8::StaticOrder S; S.init(NTOK, g.N, nb, bi);
  EpiInproj E; E.pp = &p; E.pn_lo = pn_lo;
  __syncthreads();
  pg8::gemm_phase<EpiInproj, pg8::StaticOrder>((PG8_LAS unsigned char*)smem, g, S, E);
  __syncthreads();
}

__device__ __forceinline__ void convert_ffn(const Params& p, int l, float* smem, int start, int stride);
__device__ __forceinline__ void convert_win(const Params& p, int l, float* smem, int start, int stride);
__device__ __forceinline__ void phase_resid_pg8(const Params& p, int l, int Mrows, const bf16_t* A, int K, const bf16_t* Wt, int gate_off, unsigned char* smem, bool first, int extra) {
  pg8::Gemm g; g.A = A; g.Bt = Wt; g.M = Mrows; g.N = 1024; g.K = K; g.lda = K;
  pg8::StaticOrder S; S.init(Mrows, 1024, (int)gridDim.x, (int)blockIdx.x);
  EpiResid E; E.pp = &p; E.gate_l = p.mods + (size_t)l * 17 * 6144 + gate_off; E.first = first;
  __syncthreads();
  pg8::gemm_phase<EpiResid, pg8::StaticOrder>((PG8_LAS unsigned char*)smem, g, S, E);
  __syncthreads();
  if (extra) {
    const int G = gridDim.x, bid = get_bid();
    const int nwg = (Mrows / 256) * 4;
    int nthird = nwg - 2 * G; nthird = nthird < 0 ? 0 : (nthird > G ? G : nthird);
    if (bid >= nthird && nthird < G) {
      if (extra == 1) convert_ffn(p, l, (float*)smem, bid - nthird, G - nthird);
      else convert_win(p, l + 1, (float*)smem, bid - nthird, G - nthird);
    }
  }
}

#define XB_TMO      128
#define XB_XCNT(j)  (256  + 64 * (j))
#define XB_XSUB(j)  (1280 + 64 * (j))
#define XB_XGEN(j)  (2304 + 64 * (j))
#define XB_TOP      3328
#define XB_TOPGEN   3392
#define XCD_BAR_WORDS 3456
#define XB_SPIN_CAP (1u << 18)
#define XLAS __attribute__((address_space(3)))

__device__ __forceinline__ unsigned xb_ld(unsigned* p)              { return __hip_atomic_load(p, __ATOMIC_RELAXED, __HIP_MEMORY_SCOPE_AGENT); }
__device__ __forceinline__ unsigned xb_add(unsigned* p, unsigned v) { return __hip_atomic_fetch_add(p, v, __ATOMIC_RELAXED, __HIP_MEMORY_SCOPE_AGENT); }
__device__ __forceinline__ unsigned xb_xcc_id() { return (unsigned)__builtin_amdgcn_s_getreg((3 << 11) | 20) & 0xFu; }
#define XB_SPIN(cond, bar) do { unsigned _sp = 0; while (cond) { __builtin_amdgcn_s_sleep(1); \
    if ((++_sp & 255u) == 0u) { if (xb_ld(&(bar)[XB_TMO])) break; if (_sp > XB_SPIN_CAP) { atomicAdd(&(bar)[XB_TMO], 1u); break; } } } } while (0)

struct XcdBarrier {
    unsigned* bar; unsigned x;
    volatile XLAS unsigned* st;
};

__device__ __forceinline__ XcdBarrier xcd_barrier_post(unsigned* bar, volatile XLAS unsigned* st) {
    XcdBarrier b; b.bar = bar; b.x = xb_xcc_id(); b.st = st;
    if (threadIdx.x == 0) (void)xb_add(&bar[XB_XCNT(b.x)], 1u);
    return b;
}
__device__ __forceinline__ void xcd_barrier_complete(unsigned* bar, unsigned x, unsigned& nloc, unsigned& nx) {
    const unsigned G = gridDim.x * gridDim.y * gridDim.z;
    unsigned sum, cnt, mine, sp = 0u;
    for (;;) {
        sum = 0u; cnt = 0u; mine = 0u;
#pragma unroll
        for (unsigned j = 0; j < 16; ++j) { const unsigned c = xb_ld(&bar[XB_XCNT(j)]); sum += c; cnt += (c > 0u) ? 1u : 0u; mine = (j == x) ? c : mine; }
        if (sum == G) break;
        __builtin_amdgcn_s_sleep(1);
        if ((++sp & 255u) == 0u) { if (xb_ld(&bar[XB_TMO])) break; if (sp > XB_SPIN_CAP) { atomicAdd(&bar[XB_TMO], 1u); break; } }
    }
    nloc = mine > 0u ? mine : 1u; nx = cnt > 0u ? cnt : 1u;
}

__device__ __forceinline__ void xcd_barrier(const XcdBarrier& b) {
    asm volatile("s_waitcnt vmcnt(0)" ::: "memory");
    __syncthreads();
    if (threadIdx.x == 0) {
        unsigned* bar = b.bar;
        __builtin_amdgcn_s_waitcnt(0);
        unsigned nloc = b.st[0], nx = b.st[1];
        if (nloc == 0u) { xcd_barrier_complete(bar, b.x, nloc, nx); b.st[0] = nloc; b.st[1] = nx; }
        const unsigned old = xb_add(&bar[XB_XSUB(b.x)], 1u);
        const unsigned gen = old / nloc;
        if (old + 1u == (gen + 1u) * nloc) {
            __builtin_amdgcn_fence(__ATOMIC_RELEASE, "agent");
            asm volatile("s_waitcnt vmcnt(0)" ::: "memory");
            const unsigned og = xb_add(&bar[XB_TOP], 1u);
            const unsigned tg = og / nx;
            if (og + 1u == (tg + 1u) * nx) xb_add(&bar[XB_TOPGEN], 1u);
            else XB_SPIN(xb_ld(&bar[XB_TOPGEN]) == tg, bar);
            __builtin_amdgcn_fence(__ATOMIC_ACQUIRE, "agent");
            xb_add(&bar[XB_XGEN(b.x)], 1u);
            asm volatile("s_waitcnt vmcnt(0)" ::: "memory");
        } else {
            XB_SPIN(xb_ld(&bar[XB_XGEN(b.x)]) == gen, bar);
            __builtin_amdgcn_fence(__ATOMIC_ACQUIRE, "agent");
            asm volatile("s_waitcnt vmcnt(0)" ::: "memory");
        }
    }
    __syncthreads();
}

__device__ __forceinline__ void phase_pre(const Params& p, float* smem) {
  const int tid = get_tid();
  __syncthreads();
  for (int e = tid; e < 17 * 1024; e += NTHREADS) {
    const int b = e >> 10, k = e & 1023;
    const float v = (b < 16) ? p.c[b * 1024 + k] : p.c_ctx[k];
    smem[e] = v / (1.f + expf(-v));
  }
  float* part = smem + 17 * 1024;
  __syncthreads();
  for (int job = get_bid(); job < 4 * 48; job += gridDim.x) {
    const int l = job / 48, cgp = job % 48;
    const int cl = tid & 127, kq = tid >> 7;
    const int col = cgp * 128 + cl;
    float acc[17];
#pragma unroll
    for (int b = 0; b < 17; b++) acc[b] = 0.f;
    const float* w = p.w_ada + ((size_t)l * 1024 + kq * 256) * 6144 + col;
#pragma unroll 8
    for (int k = 0; k < 256; k++) {
      const float wv = w[(size_t)k * 6144];
#pragma unroll
      for (int b = 0; b < 17; b++) acc[b] += smem[b * 1024 + kq * 256 + k] * wv;
    }
#pragma unroll
    for (int b = 0; b < 17; b++) part[(kq * 17 + b) * 128 + cl] = acc[b];
    __syncthreads();
    for (int e = tid; e < 17 * 128; e += NTHREADS) {
      const int b = e >> 7, c2 = e & 127;
      const float v = ((part[(0 * 17 + b) * 128 + c2] + part[(1 * 17 + b) * 128 + c2]) + (part[(2 * 17 + b) * 128 + c2] + part[(3 * 17 + b) * 128 + c2])) + p.b_ada[l * 6144 + cgp * 128 + c2];
      p.mods[(size_t)(l * 17 + b) * 6144 + cgp * 128 + c2] = v;
    }
    __syncthreads();
  }
  if (get_bid() == 0 && tid < 64) p.bar[tid] = 0u;
}

__device__ __forceinline__ void phase_rows_norm(const Params& p, int l, int which, int nrows, bool first = false) {
  const int tid = get_tid(), lane = tid & 63, wave = tid >> 6;
  const float* g = (which ? p.norm2_g : p.norm1_g) + l * 1024;
  const int stride = gridDim.x * 8;
  float4 gg[4];
#pragma unroll
  for (int i = 0; i < 4; i++) gg[i] = *(const float4*)(g + i * 256 + lane * 4);
  int row = get_bid() * 8 + wave;
  float4 v[4], sh[4], sc[4];
  if (row < nrows) {
    const float* xr = first ? inrow(p, row) : (const float*)xrow(p, row);
    const float* mod = p.mods + (size_t)(l * 17 + modrow(row)) * 6144 + which * 3072;
#pragma unroll
    for (int i = 0; i < 4; i++) { v[i] = *(const float4*)(xr + i * 256 + lane * 4); sh[i] = *(const float4*)(mod + i * 256 + lane * 4); sc[i] = *(const float4*)(mod + 1024 + i * 256 + lane * 4); }
  }
  for (; row < nrows; row += stride) {
    const int nrow = row + stride;
    float4 vn[4], shn[4], scn[4];
    if (nrow < nrows) {
      const float* xr = first ? inrow(p, nrow) : (const float*)xrow(p, nrow);
      const float* mod = p.mods + (size_t)(l * 17 + modrow(nrow)) * 6144 + which * 3072;
#pragma unroll
      for (int i = 0; i < 4; i++) { vn[i] = *(const float4*)(xr + i * 256 + lane * 4); shn[i] = *(const float4*)(mod + i * 256 + lane * 4); scn[i] = *(const float4*)(mod + 1024 + i * 256 + lane * 4); }
    }
    float ss = 0.f;
#pragma unroll
    for (int i = 0; i < 4; i++) ss += v[i].x * v[i].x + v[i].y * v[i].y + v[i].z * v[i].z + v[i].w * v[i].w;
#pragma unroll
    for (int o = 32; o >= 1; o >>= 1) ss += __shfl_xor(ss, o);
    const float rstd = rsqrtf(ss * (1.f / 1024.f) + 1e-6f);
#pragma unroll
    for (int i = 0; i < 4; i++) {
      const int k = i * 256 + lane * 4;
      float h0 = (v[i].x * rstd * gg[i].x) * (1.f + sc[i].x) + sh[i].x;
      float h1 = (v[i].y * rstd * gg[i].y) * (1.f + sc[i].y) + sh[i].y;
      float h2 = (v[i].z * rstd * gg[i].z) * (1.f + sc[i].z) + sh[i].z;
      float h3 = (v[i].w * rstd * gg[i].w) * (1.f + sc[i].w) + sh[i].w;
      uint2 o; o.x = pack2(h0, h1); o.y = pack2(h2, h3);
      *(uint2*)(p.H + (size_t)row * 1024 + k) = o;
    }
#pragma unroll
    for (int i = 0; i < 4; i++) { v[i] = vn[i]; sh[i] = shn[i]; sc[i] = scn[i]; }
  }
}

__device__ __forceinline__ void phase_final_norm(const Params& p) {
  const int tid = get_tid(), lane = tid & 63, wave = tid >> 6;
  for (int row = get_bid() * 8 + wave; row < NLAT; row += gridDim.x * 8) {
    float* xr = p.out + (size_t)row * DM;
    float4 v[4];
    float ss = 0.f;
#pragma unroll
    for (int i = 0; i < 4; i++) {
      v[i] = *(const float4*)(xr + i * 256 + lane * 4);
      ss += v[i].x * v[i].x + v[i].y * v[i].y + v[i].z * v[i].z + v[i].w * v[i].w;
    }
#pragma unroll
    for (int o = 32; o >= 1; o >>= 1) ss += __shfl_xor(ss, o);
    const float rstd = rsqrtf(ss * (1.f / 1024.f) + 1e-6f);
#pragma unroll
    for (int i = 0; i < 4; i++) {
      const int k = i * 256 + lane * 4;
      float4 gg = *(const float4*)(p.final_norm_g + k);
      float4 o;
      o.x = v[i].x * rstd * gg.x; o.y = v[i].y * rstd * gg.y; o.z = v[i].z * rstd * gg.z; o.w = v[i].w * rstd * gg.w;
      *(float4*)(xr + k) = o;
    }
  }
}

__device__ __forceinline__ int colmap(int mapid, int n) {
  if (mapid == 0) { if (n < 2064) return n; if (n < 2304) return -1; return n - 240; }
  if (mapid == 1) return 5136 + n;
  if (mapid == 3) { int t = n >> 8, j = n & 255; return j < 128 ? t * 128 + j : 2816 + t * 128 + (j - 128); }
  return n;
}
__device__ __forceinline__ void convert_tile(const float* __restrict__ src, int ldn, int K, bf16_t* __restrict__ dst, int mapid, int ntile, int ktile, float* smem) {
  const int tid = get_tid();
  const int n0 = ntile * 64, k0 = ktile * 64;
  __syncthreads();
#pragma unroll
  for (int i = 0; i < 8; i++) {
    int e = tid + NTHREADS * i;
    int kk = e >> 6, nn = e & 63;
    int col = colmap(mapid, n0 + nn);
    float v = (col >= 0) ? src[(size_t)(k0 + kk) * ldn + col] : 0.f;
    smem[kk * 65 + nn] = v;
  }
  __syncthreads();
  const int nn = tid >> 3, kc = (tid & 7) * 8;
  float f[8];
#pragma unroll
  for (int j = 0; j < 8; j++) f[j] = smem[(kc + j) * 65 + nn];
  uint4 o; o.x = pack2(f[0], f[1]); o.y = pack2(f[2], f[3]); o.z = pack2(f[4], f[5]); o.w = pack2(f[6], f[7]);
  *(uint4*)(dst + (size_t)(n0 + nn) * K + k0 + kc) = o;
}

__device__ __forceinline__ void phase_convert_B(const Params& p, int l, float* smem) {
  const int T0 = 768, T1 = T0 + 128, T2 = T1 + 128, T3 = T2 + 128, T4 = T3 + 256;
  for (int t = get_bid(); t < T4; t += gridDim.x) {
    if (t < T0) convert_tile(p.w_in + (size_t)l * 1024 * 8208, 8208, 1024, p.W2 + W2_G, 1, t >> 4, t & 15, smem);
    else if (t < T1) { int u = t - T0; convert_tile(p.w_pa + (size_t)l * 512 * 1024, 1024, 512, p.W2 + W2_PA, 2, u >> 3, u & 7, smem); }
    else if (t < T2) { int u = t - T1; convert_tile(p.w_pb + (size_t)l * 512 * 1024, 1024, 512, p.W2 + W2_PB, 2, u >> 3, u & 7, smem); }
    else if (t < T3) { int u = t - T2; convert_tile(p.w_pc + (size_t)l * 512 * 1024, 1024, 512, p.W2 + W2_PC, 2, u >> 3, u & 7, smem); }
    else { int u = t - T3; convert_tile(p.w_o + (size_t)l * 1024 * 1024, 1024, 1024, p.W2 + W2_O, 2, u >> 4, u & 15, smem); }
  }
}
__device__ __forceinline__ void convert_ffn(const Params& p, int l, float* smem, int start, int stride) {
  for (int t = start; t < 1408 + 704; t += stride) {
    if (t < 1408) convert_tile(p.w_up + (size_t)l * 1024 * 5632, 5632, 1024, p.W2 + W2_UP, 3, t >> 4, t & 15, smem);
    else { int u = t - 1408; convert_tile(p.w_down + (size_t)l * 2816 * 1024, 1024, 2816, p.W2 + W2_DOWN, 2, u / 44, u % 44, smem); }
  }
}
__device__ __forceinline__ void convert_win(const Params& p, int l, float* smem, int start, int stride) {
  const float* src = p.w_in + (size_t)l * 1024 * 8208;
  for (int t = start; t < 84 * 16; t += stride) convert_tile(src, 8208, 1024, p.WinT, 0, t >> 4, t & 15, smem);
}

template <int WM, int WN, bool TR>
__device__ __forceinline__ void gemm_compute(f32x4 (&acc)[4][4], const bf16_t* sb, int aoff, int boff) {
#pragma unroll
  for (int kk = 0; kk < 2; kk++) {
    bf16x8 af[4];
#pragma unroll
    for (int i = 0; i < 4; i++) af[i] = *(const bf16x8*)(sb + aoff + i * 16 * PITCH + kk * 32);
#pragma unroll
    for (int j = 0; j < 4; j++) {
      const bf16x8 bfr = *(const bf16x8*)(sb + boff + j * 16 * PITCH + kk * 32);
#pragma unroll
      for (int i = 0; i < 4; i++) acc[i][j] = TR ? mfma16(bfr, af[i], acc[i][j]) : mfma16(af[i], bfr, acc[i][j]);
    }
  }
}

template <int WM, int WN, bool DEEP, bool TR = false, class RowPtr>
__device__ __forceinline__ void gemm_mainloop(f32x4 (&acc)[4][4], RowPtr rowptr, const bf16_t* __restrict__ Bt, int ldb, int K, bf16_t* smem) {
  constexpr int TM = WM * 64, TN = WN * 64;
  constexpr int ACH = TM / 64, BCH = TN / 64;
  constexpr int STG = (TM + TN) * PITCH;
  const int tid = get_tid(), lane = tid & 63, wave = tid >> 6, wm = wave / WN, wn = wave % WN;
  const int lrow = tid >> 3, lkc = (tid & 7) * 8;
  const bf16_t* ap[ACH];
  const bf16_t* bp[BCH];
  bool av[ACH];
#pragma unroll
  for (int i = 0; i < ACH; i++) { const bf16_t* r = rowptr(lrow + 64 * i, av[i]); ap[i] = r + lkc; }
#pragma unroll
  for (int i = 0; i < BCH; i++) bp[i] = Bt + (size_t)(lrow + 64 * i) * ldb + lkc;
  const int KT = K >> 6;
  const int aoff = (wm * 64 + (lane & 15)) * PITCH + (lane >> 4) * 8;
  const int boff = TM * PITCH + (wn * 64 + (lane & 15)) * PITCH + (lane >> 4) * 8;
  const int soff = lrow * PITCH + lkc;
#define GLOAD(RA, RB, KS)                                                                                             \
  {                                                                                                                   \
    const int k0_ = (KS) << 6;                                                                                        \
    _Pragma("unroll") for (int i = 0; i < ACH; i++) { RA[i] = *(const u32x4*)(ap[i] + k0_); if (!av[i]) RA[i] = (u32x4){0u, 0u, 0u, 0u}; } \
    _Pragma("unroll") for (int i = 0; i < BCH; i++) RB[i] = *(const u32x4*)(bp[i] + k0_);                              \
  }
#define SSTORE(RA, RB, ST)                                                                                            \
  {                                                                                                                   \
    bf16_t* sd_ = smem + (ST) * STG + soff;                                                                           \
    _Pragma("unroll") for (int i = 0; i < ACH; i++) *(u32x4*)(sd_ + 64 * i * PITCH) = RA[i];                           \
    _Pragma("unroll") for (int i = 0; i < BCH; i++) *(u32x4*)(sd_ + TM * PITCH + 64 * i * PITCH) = RB[i];              \
  }
  if (DEEP) {
    u32x4 ra0[ACH], rb0[BCH], ra1[ACH], rb1[BCH];
    GLOAD(ra0, rb0, 0);
    GLOAD(ra1, rb1, 1);
    SSTORE(ra0, rb0, 0);
    __syncthreads();
    for (int kt = 0; kt < KT; kt += 2) {
      { const int kn = (kt + 2 < KT) ? kt + 2 : KT - 1; GLOAD(ra0, rb0, kn); }
      gemm_compute<WM, WN, TR>(acc, smem, aoff, boff);
      SSTORE(ra1, rb1, 1);
      __syncthreads();
      { const int kn = (kt + 3 < KT) ? kt + 3 : KT - 1; GLOAD(ra1, rb1, kn); }
      gemm_compute<WM, WN, TR>(acc, smem + STG, aoff, boff);
      SSTORE(ra0, rb0, 0);
      __syncthreads();
    }
  } else {
    u32x4 ra[ACH], rb[BCH];
    GLOAD(ra, rb, 0);
    SSTORE(ra, rb, 0);
    __syncthreads();
    for (int kt = 0; kt < KT; kt++) {
      { const int kn = (kt + 1 < KT) ? kt + 1 : kt; GLOAD(ra, rb, kn); }
      gemm_compute<WM, WN, TR>(acc, smem + (kt & 1) * STG, aoff, boff);
      SSTORE(ra, rb, (kt + 1) & 1);
      __syncthreads();
    }
  }
#undef GLOAD
#undef SSTORE
}

__device__ __forceinline__ void zero_acc(f32x4 (&acc)[4][4]) {
#pragma unroll
  for (int i = 0; i < 4; i++)
#pragma unroll
    for (int j = 0; j < 4; j++) acc[i][j] = (f32x4){0.f, 0.f, 0.f, 0.f};
}

__device__ __forceinline__ int tile_id(int round) {
  const int G = gridDim.x;
  const int bid = get_bid();
  int perm = bid;
  if ((G & 7) == 0) perm = (bid & 7) * (G >> 3) + (bid >> 3);
  return round * G + perm;
}

__device__ __forceinline__ void sub_barrier(unsigned* cnt, unsigned n) {
  asm volatile("s_waitcnt vmcnt(0)" ::: "memory");
  __syncthreads();
  if (threadIdx.x == 0) {
    __builtin_amdgcn_fence(__ATOMIC_RELEASE, "agent");
    asm volatile("s_waitcnt vmcnt(0)" ::: "memory");
    __hip_atomic_fetch_add(cnt, 1u, __ATOMIC_RELAXED, __HIP_MEMORY_SCOPE_AGENT);
    while (__hip_atomic_load(cnt, __ATOMIC_RELAXED, __HIP_MEMORY_SCOPE_AGENT) < n) __builtin_amdgcn_s_sleep(2);
    __builtin_amdgcn_fence(__ATOMIC_ACQUIRE, "agent");
    asm volatile("s_waitcnt vmcnt(0)" ::: "memory");
  }
  __syncthreads();
}

__device__ __forceinline__ void phase_inproj(const Params& p, bf16_t* smem, int nt_lo, int nt_hi, int nb, int bi) {
  const int NT = nt_hi - nt_lo, MT = 144;
  const int lane = get_tid() & 63, wave = get_tid() >> 6, wm = wave >> 1, wn = wave & 1;
  const int perm = ((nb & 7) == 0) ? (bi & 7) * (nb >> 3) + (bi >> 3) : bi;
  for (int rnd = 0;; rnd++) {
    const int id = rnd * nb + perm;
    if (rnd * nb >= MT * NT) break;
    if (id >= MT * NT) continue;
    const int band = id / (8 * NT), w = id % (8 * NT);
    const int mt = band * 8 + (w & 7), nt = nt_lo + (w >> 3);
    const int m0 = mt * 256;
    f32x4 acc[4][4];
    zero_acc(acc);
    const bf16_t* A = p.H + (size_t)m0 * 1024;
    if (nt >= 37) {
      gemm_mainloop<4, 2, true, false>(acc, [&](int r, bool& ok) { ok = true; return A + (size_t)r * 1024; }, p.WinT + (size_t)nt * 128 * 1024, 1024, 1024, smem);
#pragma unroll
      for (int i = 0; i < 4; i++) {
        const int rowb = m0 + wm * 64 + i * 16 + (lane >> 4) * 4;
        int b, tok;
        if (rowb < NLAT) { b = rowb >> 11; tok = rowb & 2047; } else { b = (rowb - NLAT) >> 8; tok = 2048 + ((rowb - NLAT) & 255); }
#pragma unroll
        for (int j = 0; j < 4; j++) {
          const int hc = (nt - 37) * 128 + wn * 64 + j * 16 + (lane & 15);
          const f32x4 v = acc[i][j];
          uint2 o; o.x = pack2(v[0], v[1]); o.y = pack2(v[2], v[3]);
          *(uint2*)(p.NVt + (size_t)(b * 512 + hc) * 2304 + tok) = o;
        }
      }
    } else {
      gemm_mainloop<4, 2, true, true>(acc, [&](int r, bool& ok) { ok = true; return A + (size_t)r * 1024; }, p.WinT + (size_t)nt * 128 * 1024, 1024, 1024, smem);
      if (nt == 16) {
        if (wn == 0) {
#pragma unroll
          for (int i = 0; i < 4; i++) {
            const int row = m0 + wm * 64 + i * 16 + (lane & 15);
            *(f32x4*)(p.AB + (size_t)row * 16 + (lane >> 4) * 4) = acc[i][0];
          }
        }
      } else {
        bf16_t* base; int ld, cb;
        if (nt < 12) { base = p.QKV; ld = 1536; cb = nt * 128; }
        else if (nt < 16) { base = p.Z; ld = 512; cb = (nt - 12) * 128; }
        else if (nt < 29) { base = p.SC; ld = 1536; cb = (nt - 17) * 128; }
        else if (nt < 33) { base = p.NQ; ld = 512; cb = (nt - 29) * 128; }
        else { base = p.NK; ld = 512; cb = (nt - 33) * 128; }
#pragma unroll
        for (int i = 0; i < 4; i++) {
          bf16_t* rowp = base + (size_t)(m0 + wm * 64 + i * 16 + (lane & 15)) * ld + cb + wn * 64 + (lane >> 4) * 4;
#pragma unroll
          for (int j = 0; j < 4; j++) {
            const f32x4 v = acc[i][j];
            uint2 o; o.x = pack2(v[0], v[1]); o.y = pack2(v[2], v[3]);
            *(uint2*)(rowp + j * 16) = o;
          }
        }
      }
    }
  }
}

__device__ __forceinline__ void phase_merge(const Params& p, int MT, bf16_t* smem) {
  const int NT = 8;
  const int tid = get_tid();
  const int lane = tid & 63, wave = tid >> 6, wm = wave >> 1, wn = wave & 1;
  float* park = (float*)p.O + (size_t)get_bid() * 65536;
  for (int rnd = 0;; rnd++) {
    const int id = tile_id(rnd);
    if (rnd * (int)gridDim.x >= MT * NT) break;
    if (id >= MT * NT) continue;
    const int band = id / (8 * NT), w = id % (8 * NT);
    const int mt = band * 8 + (w & 7), nt = w >> 3;
    const int m0 = mt * 256, n0 = nt * 128;
#pragma unroll 1
    for (int br = 0; br < 3; br++) {
      f32x4 acc[4][4];
      zero_acc(acc);
      const bf16_t* Ay; int lda;
      if (br == 0) { Ay = p.Z; lda = 512; } else if (br == 1) { Ay = p.SC; lda = 1536; } else { Ay = p.NQ; lda = 512; }
      Ay += (size_t)m0 * lda;
      gemm_mainloop<4, 2, true, true>(acc, [&](int r, bool& ok) { ok = true; return Ay + (size_t)r * lda; }, p.W2 + W2_PA + (size_t)br * 524288 + (size_t)n0 * 512, 512, 512, smem);
      {
        f32x4* pk = (f32x4*)park + tid;
        asm volatile("" : "+v"(pk));
#pragma unroll
        for (int i = 0; i < 4; i++)
#pragma unroll
          for (int j = 0; j < 4; j++) pk[(i * 4 + j) * 512] = acc[i][j];
      }
      zero_acc(acc);
      const bf16_t* Ah = p.H + (size_t)m0 * 1024;
      gemm_mainloop<4, 2, true, true>(acc, [&](int r, bool& ok) { ok = true; return Ah + (size_t)r * 1024; }, p.W2 + W2_G + (size_t)(br * 1024 + n0) * 1024, 1024, 1024, smem);
      {
        f32x4* pk = (f32x4*)park + tid;
        asm volatile("" : "+v"(pk));
        int zl = 0;
        asm volatile("" : "+v"(zl));
#pragma unroll
        for (int i = 0; i < 4; i++) {
          const int rowb = m0 + wm * 64 + i * 16 + (lane & 15);
          f32x4 yv[4], ov[4];
#pragma unroll
          for (int j = 0; j < 4; j++) yv[j] = pk[(i * 4 + j) * 512];
          if (br > 0) {
#pragma unroll
            for (int j = 0; j < 4; j++) ov[j] = pk[8192 + (i * 4 + j) * 512];
          }
#pragma unroll
          for (int j = 0; j < 4; j++) {
            const int off = rowb * 1024 + n0 + wn * 64 + j * 16 + (lane >> 4) * 4 + zl;
            f32x4 v;
#pragma unroll
            for (int r = 0; r < 4; r++) v[r] = sigmoidf(acc[i][j][r]) * yv[j][r];
            if (br > 0) v += ov[j];
            if (br < 2) pk[8192 + (i * 4 + j) * 512] = v;
            else {
              uint2 o; o.x = pack2(v[0], v[1]); o.y = pack2(v[2], v[3]);
              *(uint2*)(p.Mb + off) = o;
            }
          }
        }
      }
    }
  }
}

__device__ __forceinline__ void phase_resid_gemm(const Params& p, int l, int MT, const bf16_t* Abase, int K, const bf16_t* Wt, int gate_off, bf16_t* smem, bool first = false) {
  const int NT = 8;
  const int lane = get_tid() & 63, wave = get_tid() >> 6, wm = wave >> 1, wn = wave & 1;
  for (int rnd = 0;; rnd++) {
    const int id = tile_id(rnd);
    if (rnd * (int)gridDim.x >= MT * NT) break;
    if (id >= MT * NT) continue;
    const int band = id / (8 * NT), w = id % (8 * NT);
    const int mt = band * 8 + (w & 7), nt = w >> 3;
    const int m0 = mt * 256, n0 = nt * 128;
    f32x4 acc[4][4];
    zero_acc(acc);
    const bf16_t* A = Abase + (size_t)m0 * K;
    gemm_mainloop<4, 2, true>(acc, [&](int r, bool& ok) { ok = true; return A + (size_t)r * K; }, Wt + (size_t)n0 * K, K, K, smem);
    const float* gate = p.mods + (size_t)(l * 17 + modrow(m0)) * 6144 + gate_off;
#pragma unroll
    for (int i = 0; i < 4; i++) {
      const int rowb = m0 + wm * 64 + i * 16 + (lane >> 4) * 4;
#pragma unroll
      for (int j = 0; j < 4; j++) {
        const int col = n0 + wn * 64 + j * 16 + (lane & 15);
        const float gv = gate[col];
        float* d = xrow(p, rowb) + col;
        const float* sx = first ? inrow(p, rowb) + col : (const float*)d;
#pragma unroll
        for (int r = 0; r < 4; r++) d[(size_t)r * DM] = sx[(size_t)r * DM] + gv * acc[i][j][r];
      }
    }
  }
}

__device__ __forceinline__ void phase_ffn_up(const Params& p, int l, int MT, bf16_t* smem) {
  const int NT = 22;
  const int tid = get_tid(), lane = tid & 63, wave = tid >> 6, wm = wave >> 2, wn = wave & 3;
  float* U = (float*)smem;
  constexpr int UP = 260;
  const float* cw = p.ffn_conv_w + (size_t)l * 3 * 5632;
  const float* cb = p.ffn_conv_b + (size_t)l * 5632;
  for (int rnd = 0;; rnd++) {
    const int id = tile_id(rnd);
    if (rnd * (int)gridDim.x >= MT * NT) break;
    if (id >= MT * NT) continue;
    const int band = id / (8 * NT), w = id % (8 * NT);
    const int mt = band * 8 + (w & 7), nt = w >> 3;
    int Tseq, seqrow0, ti;
    if (mt < 272) { int b = mt / 17; ti = mt % 17; Tseq = 2048; seqrow0 = b * 2048; }
    else { int u = mt - 272; int b = u / 3; ti = u % 3; Tseq = 256; seqrow0 = NLAT + b * 256; }
    const int tstart = 126 * ti - 1;
    const int ca = nt * 128 + 2 * (tid & 63), cbn = 2816 + nt * 128 + 2 * (tid & 63);
    const f32x2_t wa0 = *(const f32x2_t*)(cw + ca), wa1 = *(const f32x2_t*)(cw + 5632 + ca), wa2 = *(const f32x2_t*)(cw + 2 * 5632 + ca), ba = *(const f32x2_t*)(cb + ca);
    const f32x2_t wb0 = *(const f32x2_t*)(cw + cbn), wb1 = *(const f32x2_t*)(cw + 5632 + cbn), wb2 = *(const f32x2_t*)(cw + 2 * 5632 + cbn), bb = *(const f32x2_t*)(cb + cbn);
    f32x4 acc[4][4];
    zero_acc(acc);
    const bf16_t* Hb = p.H;
    gemm_mainloop<2, 4, true, true>(acc, [&](int r, bool& ok) -> const bf16_t* { int t = tstart + r; ok = (t >= 0 && t < Tseq); int tc = ok ? t : 0; return Hb + (size_t)(seqrow0 + tc) * 1024; },
                        p.W2 + W2_UP + (size_t)nt * 256 * 1024, 1024, 1024, smem);
#pragma unroll
    for (int i = 0; i < 4; i++)
#pragma unroll
      for (int j = 0; j < 4; j++)
        *(f32x4*)(U + (wm * 64 + i * 16 + (lane & 15)) * UP + wn * 64 + j * 16 + (lane >> 4) * 4) = acc[i][j];
    __syncthreads();
    {
      const int cp = tid & 63, strip = tid >> 6;
      const int r0 = 1 + strip * 16;
      const int r1 = (strip == 7) ? 127 : r0 + 16;
      const float* Ua = U + 2 * cp;
      f32x2_t ua_m = *(const f32x2_t*)(Ua + (r0 - 1) * UP), ua_c = *(const f32x2_t*)(Ua + r0 * UP);
      f32x2_t ub_m = *(const f32x2_t*)(Ua + (r0 - 1) * UP + 128), ub_c = *(const f32x2_t*)(Ua + r0 * UP + 128);
      for (int rr = r0; rr < r1; rr++) {
        const f32x2_t ua_p = *(const f32x2_t*)(Ua + (rr + 1) * UP), ub_p = *(const f32x2_t*)(Ua + (rr + 1) * UP + 128);
        const int t = tstart + rr;
        if (t < Tseq) {
          const f32x2_t ua = wa0 * ua_m + wa1 * ua_c + wa2 * ua_p + ba;
          const f32x2_t ub = wb0 * ub_m + wb1 * ub_c + wb2 * ub_p + bb;
          const float o0 = siluf(ua[0]) * ub[0], o1 = siluf(ua[1]) * ub[1];
          *(unsigned*)(p.ACT + (size_t)(seqrow0 + t) * 2816 + nt * 128 + 2 * cp) = pack2(o0, o1);
        }
        ua_m = ua_c; ua_c = ua_p; ub_m = ub_c; ub_c = ub_p;
      }
    }
    __syncthreads();
  }
}

#define GP 136
__device__ __forceinline__ void gdn_chain(const Params& p, int l, int chain, unsigned char* smem_raw) {
  const int tid0 = get_tid();
  const int b = chain >> 3, h = (chain >> 1) & 3, dir = chain & 1;
  bf16_t* KQ  = (bf16_t*)smem_raw;
  bf16_t* Vs  = KQ + 128 * GP;
  bf16_t* VnT = Vs;
  bf16_t* QKm = Vs + 9216;
  bf16_t* Ut  = QKm + 4608;
  bf16_t* KdT = Ut + 9216;
  bf16_t* St  = KdT + 9216;
  float*  Lm  = (float*)(St + 128 * GP);
  float*  gcs = Lm + 64 * 68;
  float*  bts = gcs + 64;
  float*  egc = bts + 64;
  float*  cw_s = egc + 64;

  f32x4 Sreg[8];
#pragma unroll
  for (int i = 0; i < 8; i++) Sreg[i] = (f32x4){0.f, 0.f, 0.f, 0.f};
  __syncthreads();
  for (int e = tid0; e < 128 * GP / 8; e += NTHREADS) ((uint4*)St)[e] = make_uint4(0, 0, 0, 0);
  const float negA = -expf(p.dn_a_log[l * 8 + dir * 4 + h]);
  const float dtb = p.dn_dt_bias[l * 8 + dir * 4 + h];
  const float* cw = p.dn_conv_w + (size_t)l * 3 * 1536;
  bf16_t* Obase = p.O + (size_t)dir * NTOK * 512;

  for (int e = tid0; e < 9 * 128; e += NTHREADS) {
    const int ip = e >> 7, cc = e & 127;
    cw_s[e] = cw[(ip / 3) * 1536 + (ip % 3) * 512 + h * 128 + cc];
  }
  u32x4 pre[12];
#define GDN_PREFETCH(STEP, TID)                                                                               \
  {                                                                                                           \
    const bool ic_ = (STEP) < 4;                                                                              \
    const int n_ = ic_ ? (STEP) : (STEP) - 4, T_ = ic_ ? 256 : 2048, rb_ = ic_ ? NLAT + b * 256 : b * 2048;   \
    const int s_ = n_ * 64 + ((TID) >> 3);                                                                    \
    const int t_ = dir ? (T_ - 1 - s_) : s_;                                                                  \
    _Pragma("unroll") for (int part_ = 0; part_ < 2; part_++)                                                 \
      _Pragma("unroll") for (int i_ = 0; i_ < 3; i_++) {                                                      \
        const int tt_ = t_ + i_ - 1;                                                                          \
        const int ttc_ = (tt_ >= 0 && tt_ < T_) ? tt_ : t_;                                                   \
        const bf16_t* src_ = p.QKV + (size_t)(rb_ + ttc_) * 1536 + part_ * 512 + h * 128 + ((TID) & 7) * 16;  \
        pre[part_ * 6 + i_ * 2] = *(const u32x4*)src_; pre[part_ * 6 + i_ * 2 + 1] = *(const u32x4*)(src_ + 8); \
      }                                                                                                       \
  }
  GDN_PREFETCH(0, tid0);
  float av_pf = 0.f, bv_pf = 0.f;
  if (tid0 < 64) {
    const int t2 = dir ? (256 - 1 - tid0) : tid0;
    const float* ab = p.AB + (size_t)(NLAT + b * 256 + t2) * 16;
    av_pf = ab[dir * 4 + h]; bv_pf = ab[8 + dir * 4 + h];
  }
#pragma unroll 1
  for (int step = 0; step < 36; step++) {
    const int tid = get_tid();
    const int lane = tid & 63, wave = __builtin_amdgcn_readfirstlane(tid >> 6), g = lane >> 4, l15 = lane & 15;
    const bool isctx = step < 4;
    const int n = isctx ? step : step - 4;
    const int Tseq = isctx ? 256 : 2048;
    const int rowbase = isctx ? NLAT + b * 256 : b * 2048;
    {
      const int c = tid >> 3, cgp = tid & 7;
      const int s = n * 64 + c;
      const int t = dir ? (Tseq - 1 - s) : s;
      float cs8[8], sn8[8];
      int zl = 0;
      asm volatile("" : "+v"(zl));
      if (!isctx) {
        const float pos = (cgp < 4) ? (float)(t >> 6) : (float)(t & 63);
#pragma unroll
        for (int jj = 0; jj < 8; jj++) {
          const int f = (cgp & 3) * 8 + jj + zl;
          const float inv = exp2f(-(float)f * 0.4152410118609203f);
          const float ang = pos * inv;
          sn8[jj] = __sinf(ang); cs8[jj] = __cosf(ang);
        }
      }
      u32x4 vraw[6];
#pragma unroll
      for (int i = 0; i < 3; i++) {
        const int tt = t + i - 1;
        const int ttc = (tt >= 0 && tt < Tseq) ? tt : t;
        const bf16_t* src = p.QKV + (size_t)(rowbase + ttc) * 1536 + 1024 + h * 128 + cgp * 16;
        vraw[i * 2] = *(const u32x4*)src; vraw[i * 2 + 1] = *(const u32x4*)(src + 8);
      }
#pragma unroll
      for (int part = 0; part < 3; part++) {
        const int col0 = part * 512 + h * 128 + cgp * 16;
        float a[16];
#pragma unroll
        for (int j = 0; j < 16; j++) a[j] = 0.f;
#pragma unroll
        for (int i = 0; i < 3; i++) {
          const int tt = t + i - 1;
          const bool ok = (tt >= 0 && tt < Tseq);
          const float wsc = ok ? 1.f : 0.f;
          const u32x4 r0 = (part < 2) ? pre[(part & 1) * 6 + i * 2] : vraw[i * 2], r1 = (part < 2) ? pre[(part & 1) * 6 + i * 2 + 1] : vraw[i * 2 + 1];
          const float* wv = cw_s + (i * 3 + part) * 128 + cgp * 16 + zl;
          float4 w0 = *(const float4*)wv, w1 = *(const float4*)(wv + 4), w2 = *(const float4*)(wv + 8), w3 = *(const float4*)(wv + 12);
          w0.x *= wsc; w0.y *= wsc; w0.z *= wsc; w0.w *= wsc; w1.x *= wsc; w1.y *= wsc; w1.z *= wsc; w1.w *= wsc;
          w2.x *= wsc; w2.y *= wsc; w2.z *= wsc; w2.w *= wsc; w3.x *= wsc; w3.y *= wsc; w3.z *= wsc; w3.w *= wsc;
          a[0] += w0.x * lo2f(r0.x); a[1] += w0.y * hi2f(r0.x); a[2] += w0.z * lo2f(r0.y); a[3] += w0.w * hi2f(r0.y);
          a[4] += w1.x * lo2f(r0.z); a[5] += w1.y * hi2f(r0.z); a[6] += w1.z * lo2f(r0.w); a[7] += w1.w * hi2f(r0.w);
          a[8] += w2.x * lo2f(r1.x); a[9] += w2.y * hi2f(r1.x); a[10] += w2.z * lo2f(r1.y); a[11] += w2.w * hi2f(r1.y);
          a[12] += w3.x * lo2f(r1.z); a[13] += w3.y * hi2f(r1.z); a[14] += w3.z * lo2f(r1.w); a[15] += w3.w * hi2f(r1.w);
        }
#pragma unroll
        for (int j = 0; j < 16; j++) a[j] = a[j] * __builtin_amdgcn_rcpf(1.f + __expf(-a[j]));
        if (part < 2) {
          float ss = 0.f;
#pragma unroll
          for (int j = 0; j < 16; j++) ss += a[j] * a[j];
          ss += __shfl_xor(ss, 1); ss += __shfl_xor(ss, 2); ss += __shfl_xor(ss, 4);
          float sc = rsqrtf(ss + 1e-6f);
#pragma unroll
          for (int j = 0; j < 16; j++) a[j] *= sc;
          if (!isctx) {
#pragma unroll
            for (int jj = 0; jj < 8; jj++) {
              const float x1 = a[2 * jj], x2 = a[2 * jj + 1];
              a[2 * jj] = x1 * cs8[jj] - x2 * sn8[jj];
              a[2 * jj + 1] = x1 * sn8[jj] + x2 * cs8[jj];
            }
          }
          if (part == 0) {
#pragma unroll
            for (int j = 0; j < 16; j++) a[j] *= 0.08838834764831845f;
          }
        }
        bf16_t* dst = (part == 0) ? KQ + (64 + c) * GP + cgp * 16 : (part == 1) ? KQ + c * GP + cgp * 16 : Vs + c * GP + cgp * 16;
        uint4 o0, o1;
        o0.x = pack2(a[0], a[1]); o0.y = pack2(a[2], a[3]); o0.z = pack2(a[4], a[5]); o0.w = pack2(a[6], a[7]);
        o1.x = pack2(a[8], a[9]); o1.y = pack2(a[10], a[11]); o1.z = pack2(a[12], a[13]); o1.w = pack2(a[14], a[15]);
        *(uint4*)dst = o0; *(uint4*)(dst + 8) = o1;
      }
      if (step + 1 < 36) GDN_PREFETCH(step + 1, tid);
      if (wave == 0) {
        const int cc = tid;
        const float av = av_pf + dtb, bv = bv_pf;
        if (step + 1 < 36) {
          const int st2 = step + 1;
          const bool ic2 = st2 < 4;
          const int n2 = ic2 ? st2 : st2 - 4;
          const int T2 = ic2 ? 256 : 2048;
          const int rb2 = ic2 ? NLAT + b * 256 : b * 2048;
          const int s2 = n2 * 64 + cc;
          const int t2 = dir ? (T2 - 1 - s2) : s2;
          const float* ab = p.AB + (size_t)(rb2 + t2) * 16;
          av_pf = ab[dir * 4 + h]; bv_pf = ab[8 + dir * 4 + h];
        }
        const float sp = (av > 20.f) ? av : log1pf(expf(av));
        float gc = negA * sp;
#pragma unroll
        for (int o = 1; o < 64; o <<= 1) { float tv = __shfl_up(gc, o); if (lane >= o) gc += tv; }
        gcs[cc] = gc; bts[cc] = 1.f / (1.f + expf(-bv)); egc[cc] = expf(gc);
      }
    }
    __syncthreads();
    const float glast = gcs[63];
    {
      f32x4 acc[4];
#pragma unroll
      for (int j = 0; j < 4; j++) acc[j] = (f32x4){0.f, 0.f, 0.f, 0.f};
#pragma unroll
      for (int kk = 0; kk < 4; kk++) {
        const bf16x8 a = *(const bf16x8*)(KQ + (wave * 16 + l15) * GP + kk * 32 + g * 8);
#pragma unroll
        for (int j = 0; j < 4; j++) {
          const bf16x8 bq = *(const bf16x8*)(KQ + (j * 16 + l15) * GP + kk * 32 + g * 8);
          acc[j] = mfma16(a, bq, acc[j]);
        }
      }
#pragma unroll
      for (int j = 0; j < 4; j++)
#pragma unroll
        for (int r = 0; r < 4; r++) {
          const int i = (wave & 3) * 16 + g * 4 + r, jc = j * 16 + l15;
          const float dec = (i >= jc) ? __expf(gcs[i] - gcs[jc]) : 0.f;
          if (wave < 4) Lm[jc * 68 + i] = (i > jc) ? bts[i] * acc[j][r] * dec : 0.f;
          else QKm[i * PITCH + jc] = f2bf(acc[j][r] * dec);
        }
      const int dk = tid & 127, c0 = (tid >> 7) * 16;
      float kv[16];
#pragma unroll
      for (int jj = 0; jj < 16; jj++) kv[jj] = bf2f(KQ[(c0 + jj) * GP + dk]) * __expf(glast - gcs[c0 + jj]);
      uint4 o0, o1;
      o0.x = pack2(kv[0], kv[1]); o0.y = pack2(kv[2], kv[3]); o0.z = pack2(kv[4], kv[5]); o0.w = pack2(kv[6], kv[7]);
      o1.x = pack2(kv[8], kv[9]); o1.y = pack2(kv[10], kv[11]); o1.z = pack2(kv[12], kv[13]); o1.w = pack2(kv[14], kv[15]);
      *(uint4*)(KdT + dk * PITCH + c0) = o0; *(uint4*)(KdT + dk * PITCH + c0 + 8) = o1;
    }
    __syncthreads();
    if (wave < 4) {
      const bool isu = wave < 2;
      const int col = tid & 127;
#pragma unroll 1
      for (int I = 0; I < 4; I++) {
        f32x2_t rp[8];
#pragma unroll
        for (int m = 0; m < 8; m++) {
          const int c0 = I * 16 + 2 * m;
          if (isu) rp[m] = (f32x2_t){bts[c0] * bf2f(Vs[c0 * GP + col]), bts[c0 + 1] * bf2f(Vs[(c0 + 1) * GP + col])};
          else rp[m] = (f32x2_t){bts[c0] * egc[c0] * bf2f(KQ[c0 * GP + col]), bts[c0 + 1] * egc[c0 + 1] * bf2f(KQ[(c0 + 1) * GP + col])};
        }
#pragma unroll 1
        for (int j8 = 0; j8 < 2 * I; j8++) {
          float xj[8];
          if (isu) {
            const uint4 xv = *(const uint4*)(Ut + col * PITCH + j8 * 8);
            xj[0] = lo2f(xv.x); xj[1] = hi2f(xv.x); xj[2] = lo2f(xv.y); xj[3] = hi2f(xv.y);
            xj[4] = lo2f(xv.z); xj[5] = hi2f(xv.z); xj[6] = lo2f(xv.w); xj[7] = hi2f(xv.w);
          } else {
#pragma unroll
            for (int q = 0; q < 8; q++) xj[q] = bf2f(KQ[(j8 * 8 + q) * GP + col]);
          }
#pragma unroll
          for (int q = 0; q < 8; q++) {
            const float4* Lc = (const float4*)(Lm + (j8 * 8 + q) * 68 + I * 16);
            const float4 l0 = Lc[0], l1 = Lc[1], l2 = Lc[2], l3 = Lc[3];
            const float x = xj[q];
            rp[0] -= (f32x2_t){l0.x, l0.y} * x; rp[1] -= (f32x2_t){l0.z, l0.w} * x;
            rp[2] -= (f32x2_t){l1.x, l1.y} * x; rp[3] -= (f32x2_t){l1.z, l1.w} * x;
            rp[4] -= (f32x2_t){l2.x, l2.y} * x; rp[5] -= (f32x2_t){l2.z, l2.w} * x;
            rp[6] -= (f32x2_t){l3.x, l3.y} * x; rp[7] -= (f32x2_t){l3.z, l3.w} * x;
          }
        }
#pragma unroll
        for (int jj = 0; jj < 15; jj++) {
          const float x = rp[jj >> 1][jj & 1];
          const float* Lc = Lm + (I * 16 + jj) * 68 + I * 16;
          if ((jj & 1) == 0) rp[jj >> 1][1] -= Lc[jj + 1] * x;
#pragma unroll
          for (int m = (jj >> 1) + 1; m < 8; m++) {
            const f32x2_t lv = *(const f32x2_t*)(Lc + 2 * m);
            rp[m] -= lv * x;
          }
        }
        if (isu) {
          uint4 o0, o1;
          o0.x = pack2(rp[0][0], rp[0][1]); o0.y = pack2(rp[1][0], rp[1][1]); o0.z = pack2(rp[2][0], rp[2][1]); o0.w = pack2(rp[3][0], rp[3][1]);
          o1.x = pack2(rp[4][0], rp[4][1]); o1.y = pack2(rp[5][0], rp[5][1]); o1.z = pack2(rp[6][0], rp[6][1]); o1.w = pack2(rp[7][0], rp[7][1]);
          *(uint4*)(Ut + col * PITCH + I * 16) = o0; *(uint4*)(Ut + col * PITCH + I * 16 + 8) = o1;
        } else {
#pragma unroll
          for (int m = 0; m < 8; m++) { KQ[(I * 16 + 2 * m) * GP + col] = f2bf(rp[m][0]); KQ[(I * 16 + 2 * m + 1) * GP + col] = f2bf(rp[m][1]); }
        }
      }
    } else {
      const int tt = tid - 256;
      const int c = tt >> 2, seg = (tt & 3) * 32;
      const float e = egc[c];
      bf16_t* qp = KQ + (64 + c) * GP + seg;
#pragma unroll
      for (int q4 = 0; q4 < 4; q4++) {
        uint4 v = *(uint4*)(qp + q4 * 8);
        v.x = pack2(lo2f(v.x) * e, hi2f(v.x) * e); v.y = pack2(lo2f(v.y) * e, hi2f(v.y) * e);
        v.z = pack2(lo2f(v.z) * e, hi2f(v.z) * e); v.w = pack2(lo2f(v.w) * e, hi2f(v.w) * e);
        *(uint4*)(qp + q4 * 8) = v;
      }
    }
    __syncthreads();
    const int mt = wave & 3, nt0 = (wave >> 2) * 4;
    f32x4 ao[4];
    {
      f32x4 av[4];
#pragma unroll
      for (int j = 0; j < 4; j++) { av[j] = (f32x4){0.f, 0.f, 0.f, 0.f}; ao[j] = (f32x4){0.f, 0.f, 0.f, 0.f}; }
#pragma unroll
      for (int kk = 0; kk < 4; kk++) {
        const bf16x8 aw = *(const bf16x8*)(KQ + (mt * 16 + l15) * GP + kk * 32 + g * 8);
        const bf16x8 aq = *(const bf16x8*)(KQ + (64 + mt * 16 + l15) * GP + kk * 32 + g * 8);
#pragma unroll
        for (int j = 0; j < 4; j++) {
          const bf16x8 bs = *(const bf16x8*)(St + ((nt0 + j) * 16 + l15) * GP + kk * 32 + g * 8);
          av[j] = mfma16(aw, bs, av[j]);
          ao[j] = mfma16(aq, bs, ao[j]);
        }
      }
#pragma unroll
      for (int j = 0; j < 4; j++) {
        const int dv = (nt0 + j) * 16 + l15;
        const uint2 u4 = *(const uint2*)(Ut + dv * PITCH + mt * 16 + g * 4);
        uint2 o;
        o.x = pack2(lo2f(u4.x) - av[j][0], hi2f(u4.x) - av[j][1]);
        o.y = pack2(lo2f(u4.y) - av[j][2], hi2f(u4.y) - av[j][3]);
        *(uint2*)(VnT + dv * PITCH + mt * 16 + g * 4) = o;
      }
    }
    __syncthreads();
    {
#pragma unroll
      for (int kk = 0; kk < 2; kk++) {
        const bf16x8 a = *(const bf16x8*)(QKm + (mt * 16 + l15) * PITCH + kk * 32 + g * 8);
#pragma unroll
        for (int j = 0; j < 4; j++) {
          const bf16x8 bv = *(const bf16x8*)(VnT + ((nt0 + j) * 16 + l15) * PITCH + kk * 32 + g * 8);
          ao[j] = mfma16(a, bv, ao[j]);
        }
      }
#pragma unroll
      for (int r = 0; r < 4; r++) {
        const int c = mt * 16 + g * 4 + r;
        const int s = n * 64 + c;
        const int t = dir ? (Tseq - 1 - s) : s;
        bf16_t* od = Obase + (size_t)(rowbase + t) * 512 + h * 128 + l15;
#pragma unroll
        for (int j = 0; j < 4; j++) od[(nt0 + j) * 16] = f2bf(ao[j][r]);
      }
      const float gl = __expf(glast);
#pragma unroll
      for (int j = 0; j < 8; j++) { Sreg[j][0] *= gl; Sreg[j][1] *= gl; Sreg[j][2] *= gl; Sreg[j][3] *= gl; }
#pragma unroll
      for (int kk = 0; kk < 2; kk++) {
        const bf16x8 a = *(const bf16x8*)(KdT + (wave * 16 + l15) * PITCH + kk * 32 + g * 8);
#pragma unroll
        for (int j = 0; j < 8; j++) {
          const bf16x8 bv = *(const bf16x8*)(VnT + (j * 16 + l15) * PITCH + kk * 32 + g * 8);
          Sreg[j] = mfma16(a, bv, Sreg[j]);
        }
      }
#pragma unroll
      for (int j = 0; j < 8; j++) {
        uint2 o; o.x = pack2(Sreg[j][0], Sreg[j][1]); o.y = pack2(Sreg[j][2], Sreg[j][3]);
        *(uint2*)(St + (j * 16 + l15) * GP + wave * 16 + g * 4) = o;
      }
    }
    __syncthreads();
  }
}

__device__ __forceinline__ void na_wave_job(const Params& p, int l, int job, const float* rpb_s, bool dry = false) {
  const int lane = get_tid() & 63, g = lane >> 4, qi = lane & 15;
  const bool latent = job < 16384;
  int b, head, r = 0, n = 0, qrow;
  if (latent) { b = job >> 10; head = (job >> 7) & 7; r = (job >> 2) & 31; n = job & 3; qrow = b * 2048 + r * 64 + n * 16 + qi; }
  else { int j = job - 16384; b = j >> 7; head = (j >> 4) & 7; qrow = NLAT + b * 256 + (j & 15) * 16 + qi; }
  const bf16_t* qp = p.NQ + (size_t)qrow * 512 + head * 64 + g * 8;
  const bf16x8 qb0 = *(const bf16x8*)qp, qb1 = *(const bf16x8*)(qp + 32);
  float m = -1e30f, lsum = 0.f;
  f32x4 oacc[4];
#pragma unroll
  for (int d = 0; d < 4; d++) oacc[d] = (f32x4){0.f, 0.f, 0.f, 0.f};
  const bf16_t* vt = p.NVt + (size_t)((b * 8 + head) * 64) * 2304;
  const float* rpb = rpb_s + head * 465;
  int rs = r - 4; rs = rs < 0 ? 0 : (rs > 24 ? 24 : rs);
  int kstart = 16 * n - 8; kstart = kstart < 0 ? 0 : (kstart > 32 ? 32 : kstart);
  const int cq = n * 16 + qi;
  int cst = cq - 8; cst = cst < 0 ? 0 : (cst > 48 ? 48 : cst);
  const int nch = latent ? 16 : 8;
  bf16x8 kf[4], vf[4];
#define NA_LOAD(CH, KF, VF)                                                                                   \
  {                                                                                                           \
    const bool loc_ = latent && (CH) < 8;                                                                     \
    int krow_, tok_;                                                                                          \
    if (loc_) { tok_ = (rs + (CH)) * 64 + kstart; krow_ = b * 2048 + tok_; }                                  \
    else { const int cj_ = latent ? (CH) - 8 : (CH); tok_ = 2048 + cj_ * 32; krow_ = NLAT + b * 256 + cj_ * 32; } \
    _Pragma("unroll") for (int t_ = 0; t_ < 2; t_++) {                                                        \
      const int kap_ = 8 * (qi >> 2) + 4 * t_ + (qi & 3);                                                     \
      const bf16_t* kp_ = p.NK + (size_t)(krow_ + kap_) * 512 + head * 64 + g * 8;                            \
      KF[2 * t_] = *(const bf16x8*)kp_; KF[2 * t_ + 1] = *(const bf16x8*)(kp_ + 32);                          \
    }                                                                                                         \
    _Pragma("unroll") for (int d_ = 0; d_ < 4; d_++) VF[d_] = *(const bf16x8*)(vt + (size_t)(d_ * 16 + qi) * 2304 + tok_ + g * 8); \
  }
  int boff[8]; unsigned okm = 0u;
#pragma unroll
  for (int k = 0; k < 8; k++) {
    const int kc = kstart + 8 * g + k;
    int cidx = kc - cq + 15; cidx = cidx < 0 ? 0 : (cidx > 30 ? 30 : cidx);
    boff[k] = cidx;
    okm |= ((kc >= cst) && (kc < cst + 16)) ? (1u << k) : 0u;
  }
#define NA_CHUNK(CH, KC, VC, KN, VN)                                                                          \
  {                                                                                                           \
    const bool local = latent && (CH) < 8;                                                                    \
    { const int chn = ((CH) + 1 < nch) ? (CH) + 1 : (CH); NA_LOAD(chn, KN, VN); }                             \
    f32x4 s[2];                                                                                               \
    _Pragma("unroll") for (int t = 0; t < 2; t++) {                                                           \
      s[t] = mfma16(KC[2 * t], qb0, (f32x4){0.f, 0.f, 0.f, 0.f});                                             \
      s[t] = mfma16(KC[2 * t + 1], qb1, s[t]);                                                                \
    }                                                                                                         \
    float sc[8];                                                                                              \
    if (local) {                                                                                              \
      const float* rb = rpb + ((rs + (CH)) - r + 7) * 31;                                                     \
      _Pragma("unroll") for (int k = 0; k < 8; k++) {                                                         \
        const float v = s[k >> 2][k & 3] * 0.18033688011112042f + rb[boff[k]];                                \
        sc[k] = ((okm >> k) & 1u) ? v : -1e30f;                                                               \
      }                                                                                                       \
    } else {                                                                                                  \
      _Pragma("unroll") for (int k = 0; k < 8; k++) sc[k] = s[k >> 2][k & 3] * 0.18033688011112042f;          \
    }                                                                                                         \
    float cmax = sc[0];                                                                                       \
    _Pragma("unroll") for (int j = 1; j < 8; j++) cmax = fmaxf(cmax, sc[j]);                                  \
    cmax = fmaxf(cmax, __shfl_xor(cmax, 16));                                                                 \
    cmax = fmaxf(cmax, __shfl_xor(cmax, 32));                                                                 \
    const float mnew = fmaxf(m, cmax);                                                                        \
    float pv[8], psum = 0.f;                                                                                  \
    _Pragma("unroll") for (int j = 0; j < 8; j++) { pv[j] = __builtin_amdgcn_exp2f(sc[j] - mnew); psum += pv[j]; } \
    psum += __shfl_xor(psum, 16);                                                                             \
    psum += __shfl_xor(psum, 32);                                                                             \
    if (__ballot(mnew != m)) {                                                                                \
      const float alpha = __builtin_amdgcn_exp2f(m - mnew);                                                   \
      lsum *= alpha;                                                                                          \
      _Pragma("unroll") for (int d = 0; d < 4; d++) { oacc[d][0] *= alpha; oacc[d][1] *= alpha; oacc[d][2] *= alpha; oacc[d][3] *= alpha; } \
      m = mnew;                                                                                               \
    }                                                                                                         \
    lsum += psum;                                                                                             \
    union { uint4 u; bf16x8 v; } pb;                                                                          \
    pb.u.x = pack2(pv[0], pv[1]); pb.u.y = pack2(pv[2], pv[3]); pb.u.z = pack2(pv[4], pv[5]); pb.u.w = pack2(pv[6], pv[7]); \
    _Pragma("unroll") for (int d = 0; d < 4; d++) oacc[d] = mfma16(VC[d], pb.v, oacc[d]);                     \
  }
  bf16x8 kn[4], vn[4];
  NA_LOAD(0, kf, vf);
#pragma unroll 1
  for (int ch = 0; ch < nch; ch += 2) {
    NA_CHUNK(ch, kf, vf, kn, vn);
    NA_CHUNK(ch + 1, kn, vn, kf, vf);
  }
#undef NA_CHUNK
#undef NA_LOAD
  if (dry && lsum >= 0.f) return;
  const float inv = 1.f / lsum;
  bf16_t* od = p.NQ + (size_t)qrow * 512 + head * 64 + g * 4;
#pragma unroll
  for (int d = 0; d < 4; d++) {
    uint2 o; o.x = pack2(oacc[d][0] * inv, oacc[d][1] * inv); o.y = pack2(oacc[d][2] * inv, oacc[d][3] * inv);
    *(uint2*)(od + d * 16) = o;
  }
}

__device__ __forceinline__ void shortconv_items(const Params& p, int l, int nrows, int start, int stride) {
  const float* w = p.sc_conv_w + (size_t)l * 3 * 512;
  for (int item = start; item < nrows * 64; item += stride) {
    const int row = item >> 6, c8 = (item & 63) * 8;
    int t, Tseq;
    if (row < NLAT) { t = row & 2047; Tseq = 2048; } else { t = (row - NLAT) & 255; Tseq = 256; }
    float a[8];
#pragma unroll
    for (int j = 0; j < 8; j++) a[j] = 0.f;
#pragma unroll
    for (int i = 0; i < 3; i++) {
      const int tt = t + i - 1;
      if (tt >= 0 && tt < Tseq) {
        const bf16_t* src = p.SC + (size_t)(row + i - 1) * 1536 + c8;
        const uint4 cv = *(const uint4*)(src + 512), hv = *(const uint4*)(src + 1024);
        const float4 w0 = *(const float4*)(w + i * 512 + c8), w1 = *(const float4*)(w + i * 512 + c8 + 4);
        a[0] += w0.x * lo2f(cv.x) * lo2f(hv.x); a[1] += w0.y * hi2f(cv.x) * hi2f(hv.x);
        a[2] += w0.z * lo2f(cv.y) * lo2f(hv.y); a[3] += w0.w * hi2f(cv.y) * hi2f(hv.y);
        a[4] += w1.x * lo2f(cv.z) * lo2f(hv.z); a[5] += w1.y * hi2f(cv.z) * hi2f(hv.z);
        a[6] += w1.z * lo2f(cv.w) * lo2f(hv.w); a[7] += w1.w * hi2f(cv.w) * hi2f(hv.w);
      }
    }
    bf16_t* bp = p.SC + (size_t)row * 1536 + c8;
    const uint4 bv = *(const uint4*)bp;
    uint4 o;
    o.x = pack2(lo2f(bv.x) * a[0], hi2f(bv.x) * a[1]); o.y = pack2(lo2f(bv.y) * a[2], hi2f(bv.y) * a[3]);
    o.z = pack2(lo2f(bv.z) * a[4], hi2f(bv.z) * a[5]); o.w = pack2(lo2f(bv.w) * a[6], hi2f(bv.w) * a[7]);
    *(uint4*)bp = o;
  }
}

__device__ __forceinline__ void phase_mixers(const Params& p, int l, unsigned char* smem) {
  const int G = gridDim.x;
  const int nG = (G >= 256) ? 128 : (G / 2 > 0 ? G / 2 : 1);
  if (get_bid() < nG) {
    for (int chain = get_bid(); chain < 128; chain += nG) gdn_chain(p, l, chain, smem);
#if PROBE == 2
    for (int chain = get_bid(); chain < 128; chain += nG) gdn_chain(p, l, chain, smem);
#endif
  } else {
    const int nb = G - nG, bi = get_bid() - nG;
    phase_inproj_pg8(p, smem, 10, 21, nb, bi);
    sub_barrier(p.bar + l, (unsigned)nb);
    float* rpb_s = (float*)smem;
    for (int e = get_tid(); e < 8 * 465; e += NTHREADS) rpb_s[e] = p.na_rpb[(size_t)l * 8 * 465 + e] * 1.4426950408889634f;
    __syncthreads();
    const int wave = get_tid() >> 6;
    const int njobs = (l == 3) ? 16384 : 18432;
#if PROBE == 5
    for (int job = bi * 8 + wave; job < njobs; job += nb * 8) na_wave_job(p, l, job, rpb_s, true);
#endif
    for (int job = bi * 8 + wave; job < njobs; job += nb * 8) na_wave_job(p, l, job, rpb_s);
    const int nrows = (l == 3) ? NLAT : NTOK;
    shortconv_items(p, l, nrows, bi * NTHREADS + get_tid(), nb * NTHREADS);
  }
}

__device__ __forceinline__ void phase_gdn_final(const Params& p, int l, int nrows) {
  const int tid = get_tid(), lane = tid & 63, wave = tid >> 6;
  const float* ng = p.dn_norm_g + l * 128;
  const int col = lane * 8;
  const float4 g0 = *(const float4*)(ng + (col & 127)), g1 = *(const float4*)(ng + (col & 127) + 4);
  const int stride = gridDim.x * 8;
  int row = get_bid() * 8 + wave;
  uint4 of, ob, zv;
  if (row < nrows) {
    of = *(const uint4*)(p.O + (size_t)row * 512 + col);
    ob = *(const uint4*)(p.O + (size_t)NTOK * 512 + (size_t)row * 512 + col);
    zv = *(const uint4*)(p.Z + (size_t)row * 512 + col);
  }
  for (; row < nrows; row += stride) {
    const int nrow = row + stride;
    uint4 ofn, obn, zvn;
    if (nrow < nrows) {
      ofn = *(const uint4*)(p.O + (size_t)nrow * 512 + col);
      obn = *(const uint4*)(p.O + (size_t)NTOK * 512 + (size_t)nrow * 512 + col);
      zvn = *(const uint4*)(p.Z + (size_t)nrow * 512 + col);
    }
    float o[8];
    o[0] = lo2f(of.x) + lo2f(ob.x); o[1] = hi2f(of.x) + hi2f(ob.x); o[2] = lo2f(of.y) + lo2f(ob.y); o[3] = hi2f(of.y) + hi2f(ob.y);
    o[4] = lo2f(of.z) + lo2f(ob.z); o[5] = hi2f(of.z) + hi2f(ob.z); o[6] = lo2f(of.w) + lo2f(ob.w); o[7] = hi2f(of.w) + hi2f(ob.w);
    float ss = 0.f;
#pragma unroll
    for (int j = 0; j < 8; j++) ss += o[j] * o[j];
    ss += __shfl_xor(ss, 1); ss += __shfl_xor(ss, 2); ss += __shfl_xor(ss, 4); ss += __shfl_xor(ss, 8);
    const float rstd = rsqrtf(ss * (1.f / 128.f) + 1e-6f);
    float y[8];
    y[0] = o[0] * rstd * g0.x * siluf(lo2f(zv.x)); y[1] = o[1] * rstd * g0.y * siluf(hi2f(zv.x));
    y[2] = o[2] * rstd * g0.z * siluf(lo2f(zv.y)); y[3] = o[3] * rstd * g0.w * siluf(hi2f(zv.y));
    y[4] = o[4] * rstd * g1.x * siluf(lo2f(zv.z)); y[5] = o[5] * rstd * g1.y * siluf(hi2f(zv.z));
    y[6] = o[6] * rstd * g1.z * siluf(lo2f(zv.w)); y[7] = o[7] * rstd * g1.w * siluf(hi2f(zv.w));
    uint4 ov; ov.x = pack2(y[0], y[1]); ov.y = pack2(y[2], y[3]); ov.z = pack2(y[4], y[5]); ov.w = pack2(y[6], y[7]);
    *(uint4*)(p.Z + (size_t)row * 512 + col) = ov;
    of = ofn; ob = obn; zv = zvn;
  }
}

__global__ void __launch_bounds__(NTHREADS) fwd_megakernel(Params p) {
  extern __shared__ __attribute__((aligned(16))) unsigned char smem[];
  cg::grid_group grid = cg::this_grid();
  volatile XLAS unsigned* xst = (volatile XLAS unsigned*)(smem + LDS_BYTES - 16);
  if (threadIdx.x == 0) { xst[0] = 0u; xst[1] = 0u; }
  __syncthreads();
  XcdBarrier xb = xcd_barrier_post(p.xbar, xst);
  phase_pre(p, (float*)smem);
  grid.sync();
#pragma unroll 1
  for (int l = 0; l < 4; l++) {
    const bool last = (l == 3);
    phase_rows_norm(p, l, 0, NTOK, l == 0);
    if (l == 0) convert_win(p, 0, (float*)smem, get_bid(), gridDim.x);
    xcd_barrier(xb);
    phase_inproj_pg8(p, smem, 0, 10, gridDim.x, get_bid());
    xcd_barrier(xb);
    phase_mixers(p, l, smem);
    xcd_barrier(xb);
    phase_gdn_final(p, l, last ? NLAT : NTOK);
    phase_convert_B(p, l, (float*)smem);
    xcd_barrier(xb);
    phase_merge(p, last ? 128 : 144, (bf16_t*)smem);
#if PROBE == 3
    xcd_barrier(xb); phase_merge(p, last ? 128 : 144, (bf16_t*)smem);
#endif
    xcd_barrier(xb);
    phase_resid_pg8(p, l, last ? NLAT : NTOK, p.Mb, 1024, p.W2 + W2_O, 2048, smem, l == 0, 1);
    xcd_barrier(xb);
    phase_rows_norm(p, l, 1, last ? NLAT : NTOK);
    xcd_barrier(xb);
    phase_ffn_up(p, l, last ? 272 : 320, (bf16_t*)smem);
#if PROBE == 4
    xcd_barrier(xb); phase_ffn_up(p, l, last ? 272 : 320, (bf16_t*)smem);
#endif
    xcd_barrier(xb);
    phase_resid_pg8(p, l, last ? NLAT : NTOK, p.ACT, 2816, p.W2 + W2_DOWN, 5120, smem, false, last ? 0 : 2);
    xcd_barrier(xb);
  }
  phase_final_norm(p);
}

extern "C" void kernel_launch(void* const* d_in, const int* in_sizes, int n_in, void* d_out, int out_size, void* d_ws, size_t ws_size,
                              hipStream_t stream) {
  static int grid_blocks = 0;
  if (!grid_blocks) {
    int dev = 0, cus = 0, per_cu = 0;
    hipGetDevice(&dev);
    hipDeviceGetAttribute(&cus, hipDeviceAttributeMultiprocessorCount, dev);
    hipFuncSetAttribute((const void*)fwd_megakernel, hipFuncAttributeMaxDynamicSharedMemorySize, LDS_BYTES);
    hipOccupancyMaxActiveBlocksPerMultiprocessor(&per_cu, fwd_megakernel, NTHREADS, LDS_BYTES);
    if (per_cu < 1) { fprintf(stderr, "occupancy query returned %d\n", per_cu); per_cu = 1; }
    grid_blocks = cus * 1;
    (void)hipGetLastError();
  }
  Params p{};
  const float** ins = (const float**)&p;
  for (int i = 0; i < 24; i++) ins[i] = (const float*)d_in[i];
  p.out = (float*)d_out;
  unsigned char* ws = (unsigned char*)d_ws;
  size_t off = 0;
  auto take = [&](size_t bytes) { unsigned char* r = ws + off; off += (bytes + 255) & ~(size_t)255; return r; };
  p.mods = (float*)take((size_t)4 * 17 * 6144 * 4);
  p.xc = (float*)take((size_t)NCTX * DM * 4);
  p.H = (bf16_t*)take((size_t)NTOK * 1024 * 2);
  p.WinT = (bf16_t*)take((size_t)5376 * 1024 * 2);
  p.QKV = (bf16_t*)take((size_t)NTOK * 1536 * 2);
  p.Z = (bf16_t*)take((size_t)NTOK * 512 * 2);
  p.AB = (float*)take((size_t)NTOK * 16 * 4);
  p.SC = (bf16_t*)take((size_t)NTOK * 1536 * 2);
  p.NQ = (bf16_t*)take((size_t)NTOK * 512 * 2);
  p.NK = (bf16_t*)take((size_t)NTOK * 512 * 2);
  p.NVt = (bf16_t*)take((size_t)8192 * 2304 * 2);
  p.O = (bf16_t*)take((size_t)2 * NTOK * 512 * 2);
  p.Mb = p.QKV;
  p.W2 = p.QKV + (size_t)NTOK * 1024;
  p.ACT = p.SC;
  p.bar = (unsigned*)take(256);
  p.xbar = (unsigned*)take((size_t)XCD_BAR_WORDS * 4);
  if (off > ws_size) { fprintf(stderr, "workspace too small: need %zu have %zu\n", off, ws_size); return; }
  (void)hipMemsetAsync(p.xbar, 0, (size_t)XCD_BAR_WORDS * 4, stream);
  void* args[] = {&p};
  hipError_t e = hipLaunchCooperativeKernel((void*)fwd_megakernel, dim3(grid_blocks), dim3(NTHREADS), args, LDS_BYTES, stream);
  if (e != hipSuccess) fprintf(stderr, "cooperative launch failed: %s (grid %d)\n", hipGetErrorString(e), grid_blocks);
}
```
